# Optimizing an MI355X kernel written in HIP

```python
import jax, jax.numpy as jnp
from jax import lax
import numpy as np

D_MODEL = 1024
BATCH = 16
SEQ = 2048
DEPTH = 1

GDN_HEADS = 8
GDN_DK = 128
GDN_DV = 128
GDN_CONV = 4
GDN_CHUNK = 64
FOX_HEADS = 8
FOX_DH = 128
FOX_BLOCK = 128
D_FF = 4 * D_MODEL
EPS = 1e-6

GDN_QK_W = GDN_HEADS * GDN_DK
GDN_V_W = GDN_HEADS * GDN_DV
FOX_W = FOX_HEADS * FOX_DH
IN_SPLITS = (GDN_QK_W, GDN_QK_W, GDN_V_W, GDN_V_W, GDN_HEADS, GDN_HEADS,
             FOX_W, FOX_W, FOX_W, FOX_HEADS, D_MODEL, D_MODEL)
N_IN = sum(IN_SPLITS)

kernel_name = "hybrid_gdn_fox_gated_merge_block"


def rmsnorm(x, g):
    xf = x.astype(jnp.float32)
    y = xf * lax.rsqrt(jnp.mean(xf * xf, axis=-1, keepdims=True) + EPS)
    return (y * g.astype(jnp.float32)).astype(x.dtype)


def l2norm(x):
    xf = x.astype(jnp.float32)
    return xf * lax.rsqrt(jnp.sum(xf * xf, axis=-1, keepdims=True) + EPS)


def to_heads(x, n_heads):
    b, t, w = x.shape
    return x.reshape(b, t, n_heads, w // n_heads).transpose(0, 2, 1, 3)


def causal_depthwise_conv(x, w):
    k_width = w.shape[0]
    t = x.shape[1]
    xp = jnp.pad(x, ((0, 0), (k_width - 1, 0), (0, 0)))
    y = xp[:, 0:t] * w[0]
    for i in range(1, k_width):
        y = y + xp[:, i:i + t] * w[i]
    return y


def gated_delta_rule_chunked(q, k, v, g, beta):
    b, h, t, dk = q.shape
    dv = v.shape[-1]
    c = GDN_CHUNK
    n = t // c
    q = q.reshape(b, h, n, c, dk)
    k = k.reshape(b, h, n, c, dk)
    v = v.reshape(b, h, n, c, dv)
    g = g.reshape(b, h, n, c)
    beta = beta.reshape(b, h, n, c)

    G = jnp.cumsum(g, axis=-1)
    diff = G[..., :, None] - G[..., None, :]
    tri_incl = jnp.tril(jnp.ones((c, c), dtype=bool))
    tri_strict = jnp.tril(jnp.ones((c, c), dtype=bool), -1)
    decay = jnp.where(tri_incl, jnp.exp(jnp.where(tri_incl, diff, 0.0)), 0.0)

    kk = jnp.einsum('bhncd,bhnsd->bhncs', k, k)
    a_mat = jnp.where(tri_strict, beta[..., None] * kk * decay, 0.0)
    eye = jnp.eye(c, dtype=jnp.float32)
    rhs = jnp.concatenate([v * beta[..., None], k * (beta * jnp.exp(G))[..., None]], axis=-1)
    a_full = jnp.broadcast_to(a_mat + eye, (b, h, n, c, c))
    sol = lax.linalg.triangular_solve(a_full, rhs, left_side=True, lower=True,
                                      unit_diagonal=True)
    value, k_cum = sol[..., :dv], sol[..., dv:]

    attn_intra = jnp.einsum('bhncd,bhnsd->bhncs', q, k) * decay
    q_dec = q * jnp.exp(G)[..., None]
    g_last = G[..., -1:]
    k_dec = k * jnp.exp(g_last - G)[..., None]
    chunk_decay = jnp.exp(g_last[..., 0])

    def step(s, inp):
        value_c, kcum_c, attn_c, qdec_c, kdec_c, dec_c = inp
        v_new = value_c - jnp.einsum('bhcd,bhde->bhce', kcum_c, s)
        o = (jnp.einsum('bhcd,bhde->bhce', qdec_c, s)
             + jnp.einsum('bhcs,bhse->bhce', attn_c, v_new))
        s = s * dec_c[..., None, None] + jnp.einsum('bhcd,bhce->bhde', kdec_c, v_new)
        return s, o

    xs = tuple(jnp.moveaxis(a, 2, 0) for a in (value, k_cum, attn_intra, q_dec, k_dec, chunk_decay))
    s0 = jnp.zeros((b, h, dk, dv), jnp.float32)
    _, o = lax.scan(step, s0, xs)
    return jnp.moveaxis(o, 0, 2).reshape(b, h, t, dv)


def forgetting_attention(q, k, v, log_f):
    t = q.shape[2]
    cum = jnp.cumsum(log_f, axis=-1)
    scale = FOX_DH ** -0.5
    outs = []
    for i in range(t // FOX_BLOCK):
        q0 = i * FOX_BLOCK
        q1 = q0 + FOX_BLOCK
        s = (jnp.einsum('bhqd,bhkd->bhqk', q[:, :, q0:q1], k[:, :, :q1]) * scale
             + cum[:, :, q0:q1, None] - cum[:, :, None, :q1])
        mask = (q0 + jnp.arange(FOX_BLOCK))[:, None] >= jnp.arange(q1)[None, :]
        p = jax.nn.softmax(jnp.where(mask, s, -jnp.inf), axis=-1)
        outs.append(jnp.einsum('bhqk,bhkd->bhqd', p, v[:, :, :q1]))
    return jnp.concatenate(outs, axis=2)


def setup_inputs(seed: int = 0) -> dict:
    key = jax.random.key(seed)
    ks = jax.random.split(key, 20)
    f32 = jnp.float32

    def nrm(k, shape, fan_in):
        return jax.random.normal(k, shape, f32) * (fan_in ** -0.5)

    def gain(k, shape):
        return 1.0 + 0.02 * jax.random.normal(k, shape, f32)

    dt = jnp.exp(jax.random.uniform(ks[5], (DEPTH, GDN_HEADS), f32,
                                    minval=float(np.log(1e-3)), maxval=float(np.log(1e-1))))
    return {
        "x": jax.random.normal(ks[0], (BATCH, SEQ, D_MODEL), f32),
        "norm_mix_g": gain(ks[1], (DEPTH, D_MODEL)),
        "w_in": nrm(ks[2], (DEPTH, D_MODEL, N_IN), D_MODEL),
        "gdn_conv_w": nrm(ks[3], (DEPTH, GDN_CONV, 2 * GDN_QK_W + GDN_V_W), GDN_CONV),
        "gdn_a_log": jnp.log(jax.random.uniform(ks[4], (DEPTH, GDN_HEADS), f32, minval=1.0, maxval=16.0)),
        "gdn_dt_bias": dt + jnp.log(-jnp.expm1(-dt)),
        "gdn_norm_g": gain(ks[6], (DEPTH, GDN_DV)),
        "fox_q_norm_g": gain(ks[7], (DEPTH, FOX_DH)),
        "fox_k_norm_g": gain(ks[8], (DEPTH, FOX_DH)),
        "fox_f_bias": jax.random.uniform(ks[9], (DEPTH, FOX_HEADS), f32, minval=2.0, maxval=6.0),
        "w_proj_gdn": nrm(ks[10], (DEPTH, GDN_V_W, D_MODEL), GDN_V_W),
        "w_proj_fox": nrm(ks[11], (DEPTH, FOX_W, D_MODEL), FOX_W),
        "w_out": nrm(ks[12], (DEPTH, D_MODEL, D_MODEL), D_MODEL),
        "norm_mlp_g": gain(ks[13], (DEPTH, D_MODEL)),
        "w_up": nrm(ks[14], (DEPTH, D_MODEL, D_FF), D_MODEL),
        "w_down": nrm(ks[15], (DEPTH, D_FF, D_MODEL), D_FF),
    }


def reference(x, norm_mix_g, w_in, gdn_conv_w, gdn_a_log, gdn_dt_bias, gdn_norm_g,
              fox_q_norm_g, fox_k_norm_g, fox_f_bias, w_proj_gdn, w_proj_fox, w_out,
              norm_mlp_g, w_up, w_down):
    f32 = jnp.float32
    b, t, _ = x.shape
    split_idx = [int(i) for i in np.cumsum(IN_SPLITS)[:-1]]
    for l in range(DEPTH):
        u = rmsnorm(x, norm_mix_g[l])
        proj = u @ w_in[l]
        (gq, gk, gv, gz, ga, gb, fq, fk, fv, ff, gate_a, gate_b) = jnp.split(proj, split_idx, axis=-1)

        qkv = jax.nn.silu(causal_depthwise_conv(jnp.concatenate([gq, gk, gv], axis=-1), gdn_conv_w[l]))
        cq, ck, cv = jnp.split(qkv, [GDN_QK_W, 2 * GDN_QK_W], axis=-1)
        qh = l2norm(to_heads(cq, GDN_HEADS)) * (GDN_DK ** -0.5)
        kh = l2norm(to_heads(ck, GDN_HEADS))
        vh = to_heads(cv, GDN_HEADS).astype(f32)
        beta = jax.nn.sigmoid(gb.astype(f32)).transpose(0, 2, 1)
        g = (-jnp.exp(gdn_a_log[l].astype(f32))
             * jax.nn.softplus(ga.astype(f32) + gdn_dt_bias[l].astype(f32))).transpose(0, 2, 1)
        o_a = gated_delta_rule_chunked(qh, kh, vh, g, beta).transpose(0, 2, 1, 3)
        z = gz.reshape(b, t, GDN_HEADS, GDN_DV).astype(f32)
        o_a = rmsnorm(o_a, gdn_norm_g[l]) * jax.nn.silu(z)
        y_a = o_a.reshape(b, t, GDN_V_W).astype(x.dtype) @ w_proj_gdn[l]

        fqh = rmsnorm(to_heads(fq, FOX_HEADS), fox_q_norm_g[l]).astype(f32)
        fkh = rmsnorm(to_heads(fk, FOX_HEADS), fox_k_norm_g[l]).astype(f32)
        fvh = to_heads(fv, FOX_HEADS).astype(f32)
        log_f = jax.nn.log_sigmoid(ff.astype(f32) + fox_f_bias[l].astype(f32)).transpose(0, 2, 1)
        o_b = forgetting_attention(fqh, fkh, fvh, log_f).transpose(0, 2, 1, 3)
        y_b = o_b.reshape(b, t, FOX_W).astype(x.dtype) @ w_proj_fox[l]

        merged = jax.nn.sigmoid(gate_a) * y_a + jax.nn.sigmoid(gate_b) * y_b
        h = x + merged @ w_out[l]

        hn = rmsnorm(h, norm_mlp_g[l])
        x = h + jnp.square(jax.nn.relu(hn @ w_up[l])) @ w_down[l]
    return x
```

```cpp
#include <hip/hip_runtime.h>
#include <hip/hip_bf16.h>
#include <hip/hip_cooperative_groups.h>
#include <cstdio>
#include <cstdint>
namespace cg = cooperative_groups;

#define LAS __attribute__((address_space(3)))
typedef unsigned short bf16_t;
typedef short bf16x8 __attribute__((ext_vector_type(8)));
typedef short s16x4 __attribute__((ext_vector_type(4)));
typedef float f32x4 __attribute__((ext_vector_type(4)));
typedef float f32x16 __attribute__((ext_vector_type(16)));
typedef float f32x2 __attribute__((ext_vector_type(2)));
typedef unsigned u32x4 __attribute__((ext_vector_type(4)));
typedef unsigned u32x2 __attribute__((ext_vector_type(2)));
typedef __bf16 bf16x2_t __attribute__((ext_vector_type(2)));

constexpr int BATCH = 16, SEQ = 2048, DM = 1024, NH = 8, HD = 128, DFF = 4096, NIN = 9240;
constexpr int MTOT = BATCH * SEQ;
constexpr int NHALF = 2, MH = MTOT / NHALF;
constexpr int BH = BATCH / NHALF;
constexpr int NPROJ = 9216;
constexpr float EPS = 1e-6f;
constexpr float SM_SCALE = 0.08838834764831845f;
constexpr int NCH = SEQ / 64;

constexpr size_t MiB = 1u << 20;
constexpr size_t WS_CTL = 0;
constexpr size_t WS_WIN = 1 * MiB;
constexpr size_t WS_WPA = 19 * MiB, WS_WPB = 21 * MiB, WS_WOUT = 23 * MiB, WS_WUP = 25 * MiB, WS_WDN = 33 * MiB;
constexpr size_t WS_SMALL = 41 * MiB;
constexpr size_t WS_CB = 44 * MiB;
constexpr size_t WS_DEC = 45 * MiB;
constexpr size_t WS_PROJ = 48 * MiB;
constexpr size_t GRP = 32 * MiB;
constexpr size_t WS_IO = 336 * MiB;
constexpr size_t WS_HSS = 45 * MiB + 65536;
constexpr size_t WS_MG0 = 480 * MiB;
constexpr size_t WS_HB = 176 * MiB;
constexpr size_t WS_ACT = 240 * MiB;
constexpr size_t WS_END = 512 * MiB;
constexpr size_t IO_STRIDE = 73728;
constexpr size_t IO_WN = 0, IO_QD = 16384, IO_KDT = 32768, IO_AT = 49152, IO_UT = 57344;
constexpr int LDS_BYTES = 163840;
#define DUP_SYNC 0
#define DUP_SA 0
#define DUP_INTRA 0
#define DUP_G1 0
#define DUP_P0 0
#define DUP_G4 0
#define DUP_G5 0
#define GSYNC() do { xcd_barrier(xbar); if (DUP_SYNC) xcd_barrier(xbar); } while (0)

__device__ __forceinline__ unsigned cvtpk(float lo, float hi) { f32x2 v = {lo, hi}; bf16x2_t b = __builtin_convertvector(v, bf16x2_t); return __builtin_bit_cast(unsigned, b); }
__device__ __forceinline__ float bflo(unsigned w) { return __uint_as_float(w << 16); }
__device__ __forceinline__ float bfhi(unsigned w) { return __uint_as_float(w & 0xffff0000u); }
__device__ __forceinline__ bf16_t f2bf(float f) { return (bf16_t)(cvtpk(f, 0.f) & 0xffffu); }
__device__ __forceinline__ float bf2f(bf16_t h) { return __uint_as_float(((unsigned)h) << 16); }
__device__ __forceinline__ float wave_sum(float v) {
#pragma unroll
    for (int o = 1; o < 64; o <<= 1) v += __shfl_xor(v, o);
    return v;
}
__device__ __forceinline__ float sigmoidf_(float x) { return __builtin_amdgcn_rcpf(1.f + __expf(-x)); }
__device__ __forceinline__ float siluf_(float x) { return x * __builtin_amdgcn_rcpf(1.f + __expf(-x)); }
__device__ __forceinline__ int otid() { int t = threadIdx.x; asm volatile("" : "+v"(t)); return t; }
#define LDS_WAIT() asm volatile("s_waitcnt lgkmcnt(0)" ::: "memory")
#define LBAR() do { asm volatile("s_waitcnt lgkmcnt(0)" ::: "memory"); __builtin_amdgcn_s_barrier(); asm volatile("" ::: "memory"); } while (0)

namespace pg8 {
constexpr int BM = 256, BK = 64, HALF = 128, HTB = HALF * BK * 2, STAGE_BYTES = 8 * HTB, NXCD = 8, WGM = 8;
__host__ __device__ __forceinline__ int lds_byte(int r, int c) { const int st = (r >> 4) * 2 + (c >> 5), rr = r & 15, cc = c & 31, ob = rr * 64 + cc * 2; return st * 1024 + (ob ^ (((ob >> 9) & 1) << 5)); }
__host__ __device__ __forceinline__ void stage_rc(int b, int& R, int& C) { const int st = b / 1024, sb = b % 1024, swz = sb ^ (((sb >> 9) & 1) << 5); R = (st >> 1) * 16 + swz / 64; C = (st & 1) * 32 + (swz % 64) / 2; }
__host__ __device__ __forceinline__ int perm32(int rho) { const int n = rho >> 4, i = rho & 15; return 8 * (i >> 2) + 4 * n + (i & 3); }
struct Unit { int pm, pn; };
struct Gemm { const bf16_t* A; const bf16_t* Bt; int M, N, K; const bf16_t* A1 = nullptr; int pm1 = 1 << 30; };
struct StaticOrder {
    int nM, nN, nwg, G, c;
    __host__ __device__ void init(int M, int N, int G_, int c_) { nM = M / BM; nN = N / BM; nwg = nM * nN; G = G_; c = c_; }
    __host__ __device__ bool next(int i, Unit& u) const {
        const long L = (long)i * G + c; if (L >= nwg) return false;
        int wgid = (int)L; { const int q = nwg / NXCD, r = nwg % NXCD, xcd = wgid % NXCD, off = wgid / NXCD; wgid = (xcd < r ? xcd * (q + 1) : r * (q + 1) + (xcd - r) * q) + off; }
        const int nig = WGM * nN, gid = wgid / nig, fm = gid * WGM, gsz = (nM - fm) < WGM ? (nM - fm) : WGM;
        u.pm = fm + ((wgid % nig) % gsz); u.pn = (wgid % nig) / gsz; return true;
    }
    __device__ __forceinline__ void a_ready(const Unit&) const {}
    __device__ __forceinline__ void done(const Unit&) const {}
};
struct TwoStageOrder {
    StaticOrder base; int dpm, dpn;
    __device__ bool next(int i, Unit& u) const { Unit b; if (!base.next(i >> 1, b)) return false; u.pm = b.pm + (i & 1) * dpm; u.pn = b.pn + (i & 1) * dpn; return true; }
    __device__ __forceinline__ void a_ready(const Unit&) const {}
    __device__ __forceinline__ void done(const Unit&) const {}
};
template <int ACT  > struct EpiBf16 {
    static constexpr bool PERM = true, AFTER_DRAIN = false;
    bf16_t* O; int ldc; int split_cols; size_t split_stride; int hm_lo, hm_hi;
    int nrm_lo, nrm_hi; const float* ng0; const float* ng1; LAS float* xl; const float* hss;
    __device__ __forceinline__ void operator()(const f32x4 (&acc)[2][2][4][2], const Unit& u, int wr, int wc, int fr, int fq) const {
        const int row0 = u.pm * BM + wr * 64 + fr; int colt = u.pn * BM; bf16_t* base = O; bool hm = false, nrm = false; const float* ng = ng0;
        if (split_cols) { const int t = colt / split_cols; base += (size_t)t * split_stride; colt -= t * split_cols; hm = t >= hm_lo && t < hm_hi; nrm = t >= nrm_lo && t < nrm_hi; if (t > nrm_lo) ng = ng1; }
        const int col0 = colt + wc * 32 + 8 * fq;
        f32x4 g0 = {1.f, 1.f, 1.f, 1.f}, g1 = g0;
        if (ACT == 0 && nrm) {
#pragma unroll
            for (int ai = 0; ai < 2; ++ai)
#pragma unroll
                for (int m = 0; m < 4; ++m)
#pragma unroll
                    for (int bj = 0; bj < 2; ++bj) { const f32x4 v0 = acc[ai][bj][m][0], v1 = acc[ai][bj][m][1];
                        float s_ = (v0[0] * v0[0] + v0[1] * v0[1]) + (v0[2] * v0[2] + v0[3] * v0[3]) + (v1[0] * v1[0] + v1[1] * v1[1]) + (v1[2] * v1[2] + v1[3] * v1[3]);
                        s_ += __shfl_xor(s_, 16); s_ += __shfl_xor(s_, 32);
                        if (fq == 0) xl[(ai * HALF + wr * 64 + m * 16 + fr) * 8 + bj * 4 + wc] = s_; }
            asm volatile("s_waitcnt lgkmcnt(0)" ::: "memory"); __builtin_amdgcn_s_barrier(); asm volatile("" ::: "memory");
            g0 = *(const f32x4*)(ng + wc * 32 + 8 * fq); g1 = *(const f32x4*)(ng + wc * 32 + 8 * fq + 4);
        }
#pragma unroll
        for (int ai = 0; ai < 2; ++ai)
#pragma unroll
            for (int m = 0; m < 4; ++m) { const int row = row0 + ai * HALF + m * 16;
                float rrow = 1.f;
                if (ACT == 2) { const f32x4 p = *(const f32x4*)(hss + (size_t)row * 4); rrow = __builtin_amdgcn_rsqf(((p[0] + p[1]) + (p[2] + p[3])) * (1.f / DM) + EPS); }
                bf16_t* rowp = hm ? base + ((size_t)((row >> 11) * NH + (colt >> 7)) * SEQ + (row & (SEQ - 1))) * HD + (wc * 32 + 8 * fq)
                                  : base + (size_t)row * ldc + col0;
                const int bstep = hm ? SEQ * HD : HALF;
#pragma unroll
                for (int bj = 0; bj < 2; ++bj) { f32x4 v0 = acc[ai][bj][m][0], v1 = acc[ai][bj][m][1];
                    if (ACT == 2) {
#pragma unroll
                        for (int i = 0; i < 4; ++i) { float a = fmaxf(v0[i] * rrow, 0.f), b = fmaxf(v1[i] * rrow, 0.f); v0[i] = a * a; v1[i] = b * b; } }
                    if (ACT == 0 && nrm) { const f32x4 p = *(const LAS f32x4*)(xl + (ai * HALF + wr * 64 + m * 16 + fr) * 8 + bj * 4);
                        const float r_ = __builtin_amdgcn_rsqf(((p[0] + p[1]) + (p[2] + p[3])) * (1.f / HD) + EPS); v0 = v0 * r_ * g0; v1 = v1 * r_ * g1; }
                    u32x4 w; w.x = cvtpk(v0[0], v0[1]); w.y = cvtpk(v0[2], v0[3]); w.z = cvtpk(v1[0], v1[1]); w.w = cvtpk(v1[2], v1[3]);
                    *(u32x4*)(rowp + bj * bstep) = w; } }
    }
};
struct EpiGate {
    static constexpr bool PERM = true, AFTER_DRAIN = false;
    const bf16_t* G0; const bf16_t* G1; bf16_t* Mg; int pm1, pn1;
    __device__ __forceinline__ void operator()(const f32x4 (&acc)[2][2][4][2], const Unit& u, int wr, int wc, int fr, int fq) const {
        const bool accum = u.pm >= pm1; const bf16_t* G = accum ? G1 : G0;
        const int pm = accum ? u.pm - pm1 : u.pm, pn = accum ? u.pn - pn1 : u.pn;
        const int row0 = pm * BM + wr * 64 + fr; const int col0 = pn * BM + wc * 32 + 8 * fq;
#pragma unroll
        for (int ai = 0; ai < 2; ++ai)
#pragma unroll
            for (int m = 0; m < 4; ++m) { const size_t ro = (size_t)(row0 + ai * HALF + m * 16) * DM + col0;
#pragma unroll
                for (int bj = 0; bj < 2; ++bj) { const f32x4 v0 = acc[ai][bj][m][0], v1 = acc[ai][bj][m][1];
                    const u32x4 g = *(const u32x4*)(G + ro + bj * HALF);
                    float r[8];
                    r[0] = sigmoidf_(bflo(g.x)) * v0[0]; r[1] = sigmoidf_(bfhi(g.x)) * v0[1]; r[2] = sigmoidf_(bflo(g.y)) * v0[2]; r[3] = sigmoidf_(bfhi(g.y)) * v0[3];
                    r[4] = sigmoidf_(bflo(g.z)) * v1[0]; r[5] = sigmoidf_(bfhi(g.z)) * v1[1]; r[6] = sigmoidf_(bflo(g.w)) * v1[2]; r[7] = sigmoidf_(bfhi(g.w)) * v1[3];
                    if (accum) { u32x4 o;
                        { const unsigned long long* mp = (const unsigned long long*)(Mg + ro + bj * HALF);
                          const unsigned long long lo = __hip_atomic_load(mp, __ATOMIC_RELAXED, __HIP_MEMORY_SCOPE_AGENT), hi2 = __hip_atomic_load(mp + 1, __ATOMIC_RELAXED, __HIP_MEMORY_SCOPE_AGENT);
                          o.x = (unsigned)lo; o.y = (unsigned)(lo >> 32); o.z = (unsigned)hi2; o.w = (unsigned)(hi2 >> 32); }
                        r[0] += bflo(o.x); r[1] += bfhi(o.x); r[2] += bflo(o.y); r[3] += bfhi(o.y); r[4] += bflo(o.z); r[5] += bfhi(o.z); r[6] += bflo(o.w); r[7] += bfhi(o.w); }
                    u32x4 w; w.x = cvtpk(r[0], r[1]); w.y = cvtpk(r[2], r[3]); w.z = cvtpk(r[4], r[5]); w.w = cvtpk(r[6], r[7]);
                    *(u32x4*)(Mg + ro + bj * HALF) = w; }
                asm volatile("" ::: "memory"); }
    }
};
template <bool STATS> struct EpiResF32 {
    static constexpr bool PERM = false, AFTER_DRAIN = false;
    const float* base; float* out; bf16_t* hb; float* hss; LAS float* xl;
    __device__ __forceinline__ void operator()(const f32x4 (&acc)[2][2][4][2], const Unit& u, int wr, int wc, int fr, int fq) const {
        const int row0 = u.pm * BM + wr * 64 + fr; const int col0 = u.pn * BM + wc * 32 + 4 * fq;
#pragma unroll
        for (int ai = 0; ai < 2; ++ai)
#pragma unroll
            for (int m = 0; m < 4; ++m) { const size_t ro = (size_t)(row0 + ai * HALF + m * 16) * DM + col0; float s_ = 0.f;
#pragma unroll
                for (int bj = 0; bj < 2; ++bj)
#pragma unroll
                    for (int n = 0; n < 2; ++n) { const size_t o = ro + bj * HALF + n * 16; const f32x4 b = *(const f32x4*)(base + o); const f32x4 h = b + acc[ai][bj][m][n]; *(f32x4*)(out + o) = h;
                        if (STATS) { u32x2 w; w.x = cvtpk(h[0], h[1]); w.y = cvtpk(h[2], h[3]); *(u32x2*)(hb + o) = w; s_ += (h[0] * h[0] + h[1] * h[1]) + (h[2] * h[2] + h[3] * h[3]); }
                        asm volatile("" ::: "memory"); }
                if (STATS) { s_ += __shfl_xor(s_, 16); s_ += __shfl_xor(s_, 32); if (fq == 0) xl[(ai * HALF + wr * 64 + m * 16 + fr) * 4 + wc] = s_; }
                asm volatile("" ::: "memory"); }
        if (STATS) {
            asm volatile("s_waitcnt lgkmcnt(0)" ::: "memory"); __builtin_amdgcn_s_barrier(); asm volatile("" ::: "memory");
            const int t_ = (int)(wr * 4 + wc) * 64 + (fq * 16 + fr);
            if (t_ < 256) { const f32x4 p = *(const LAS f32x4*)(xl + t_ * 4); hss[(size_t)(u.pm * BM + t_) * 4 + u.pn] = (p[0] + p[1]) + (p[2] + p[3]); }
        }
    }
};

template <class Epi, class Sched, bool ALIGN_EPI = false>
__device__ __forceinline__ void gemm_phase(LAS unsigned char* lds, const Gemm g, const Sched& S, const Epi& E) {
    const int tid = otid(), wid = __builtin_amdgcn_readfirstlane(tid >> 6), lane = tid & 63, wr = wid >> 2, wc = wid & 3, fr = lane & 15, fq = lane >> 4;
    const int K = g.K, nt = K / BK;
    unsigned voffA[2], voffB[2];
#pragma unroll
    for (int i = 0; i < 2; ++i) { int R, C; stage_rc(tid * 16 + i * 8192, R, C); const int Rb = Epi::PERM ? ((R & ~31) + perm32(R & 31)) : R;
        voffA[i] = (unsigned)(R * K + C) * 2u; voffB[i] = (unsigned)(Rb * K + C) * 2u; }
    const size_t kstep = (size_t)(BK * 2);
    const size_t hstep = (size_t)HALF * K * 2;
    const size_t tstep = 2 * hstep;
    const unsigned ldsw = (unsigned)wid * 1024u;
    const int aoff = lds_byte(wr * 64 + fr, fq * 8), boff = lds_byte(wc * 32 + fr, fq * 8);
#define PG8_SA(b, h) (((b) * 2 + (h)) * HTB)
#define PG8_SB(b, h) ((4 + (b) * 2 + (h)) * HTB)
#define PG8_STAGE(bufoff, gbase, voff) do { _Pragma("unroll") for (int _i = 0; _i < 2; ++_i) \
        __builtin_amdgcn_global_load_lds((const unsigned*)((const char*)(gbase) + (voff)[_i]), (LAS unsigned*)(lds + (bufoff) + ldsw + _i * 8192), 16, 0, 0); } while (0)
#define PG8_LDA(dst, b, h) do { _Pragma("unroll") for (int m = 0; m < 4; ++m) _Pragma("unroll") for (int k = 0; k < 2; ++k) dst[m][k] = *(const LAS bf16x8*)(lds + PG8_SA(b, h) + aoff + m * 2048 + k * 1024); } while (0)
#define PG8_LDB(dst, b, h) do { _Pragma("unroll") for (int n = 0; n < 2; ++n) _Pragma("unroll") for (int k = 0; k < 2; ++k) dst[n][k] = *(const LAS bf16x8*)(lds + PG8_SB(b, h) + boff + n * 2048 + k * 1024); } while (0)
#define PG8_MMA(ai, bj, At, Bt) do { __builtin_amdgcn_s_setprio(1); _Pragma("unroll") for (int m = 0; m < 4; ++m) _Pragma("unroll") for (int n = 0; n < 2; ++n) _Pragma("unroll") for (int k = 0; k < 2; ++k) \
        acc[ai][bj][m][n] = __builtin_amdgcn_mfma_f32_16x16x32_bf16(Bt[n][k], At[m][k], acc[ai][bj][m][n], 0, 0, 0); __builtin_amdgcn_s_setprio(0); } while (0)
#define PG8_WAIT_V(n) asm volatile("s_waitcnt vmcnt(" #n ")" ::: "memory")
#define PG8_WAIT_L(n) asm volatile("s_waitcnt lgkmcnt(" #n ")" ::: "memory")
#define PG8_BAR __builtin_amdgcn_s_barrier()
#define PG8_SCHED __builtin_amdgcn_sched_barrier(0)
    Unit cur, nxt; int ui = 0;
    if (!S.next(0, cur)) return;
    f32x4 acc[2][2][4][2];
#pragma unroll
    for (int a = 0; a < 2; ++a)
#pragma unroll
        for (int b = 0; b < 2; ++b)
#pragma unroll
            for (int m = 0; m < 4; ++m)
#pragma unroll
                for (int n = 0; n < 2; ++n) acc[a][b][m][n] = (f32x4){0.f, 0.f, 0.f, 0.f};
    bf16x8 At[4][2], B0[2][2], B1[2][2];
#define PG8_ABASE(pm_) ((const char*)g.A + ((pm_) >= g.pm1 ? (ptrdiff_t)((const char*)g.A1 - (const char*)g.A) + (ptrdiff_t)((size_t)((pm_) - g.pm1) * tstep) : (ptrdiff_t)((size_t)(pm_) * tstep)))
    const char* cA = PG8_ABASE(cur.pm); const char* cB = (const char*)g.Bt + (size_t)cur.pn * tstep;
    PG8_STAGE(PG8_SB(0, 0), cB, voffB); PG8_STAGE(PG8_SB(0, 1), cB + hstep, voffB); PG8_STAGE(PG8_SA(0, 0), cA, voffA); PG8_STAGE(PG8_SA(0, 1), cA + hstep, voffA);
    if (wr == 1) PG8_BAR;
    PG8_WAIT_V(2); PG8_BAR;
    PG8_STAGE(PG8_SB(1, 0), cB + kstep, voffB); PG8_STAGE(PG8_SA(1, 0), cA + kstep, voffA); PG8_STAGE(PG8_SB(1, 1), cB + hstep + kstep, voffB);
    PG8_WAIT_V(6); PG8_BAR;
    for (;;) {
        const bool has_next = S.next(ui + 1, nxt);
        const char* nA = has_next ? PG8_ABASE(nxt.pm) : cA; const char* nB = has_next ? (const char*)g.Bt + (size_t)nxt.pn * tstep : cB;
        for (int t = 0; t < nt; t += 2) {
            const bool last = (t == nt - 2);
            const char* a1 = cA + (size_t)(t + 1) * kstep;
            const char* a2 = last ? nA : cA + (size_t)(t + 2) * kstep; const char* b2 = last ? nB : cB + (size_t)(t + 2) * kstep;
            const char* a3 = a2 + kstep; const char* b3 = b2 + kstep;
            PG8_LDB(B0, 0, 0); PG8_LDB(B1, 0, 1); PG8_SCHED; PG8_LDA(At, 0, 0); PG8_STAGE(PG8_SA(1, 1), a1 + hstep, voffA);
            PG8_WAIT_V(8); PG8_WAIT_L(0); PG8_BAR; PG8_MMA(0, 0, At, B0); PG8_MMA(0, 1, At, B1); PG8_BAR; PG8_SCHED;
            PG8_LDA(At, 0, 1); PG8_STAGE(PG8_SB(0, 0), b2, voffB); PG8_STAGE(PG8_SB(0, 1), b2 + hstep, voffB); PG8_STAGE(PG8_SA(0, 0), a2, voffA);
            PG8_WAIT_V(8); PG8_WAIT_L(0); PG8_BAR; PG8_MMA(1, 0, At, B0); PG8_MMA(1, 1, At, B1); PG8_BAR; PG8_SCHED;
            PG8_LDB(B0, 1, 0); PG8_LDB(B1, 1, 1); PG8_SCHED; PG8_LDA(At, 1, 0); PG8_STAGE(PG8_SA(0, 1), a2 + hstep, voffA);
            PG8_WAIT_V(8); PG8_WAIT_L(0); PG8_BAR; PG8_MMA(0, 0, At, B0); PG8_MMA(0, 1, At, B1); PG8_BAR; PG8_SCHED;
            PG8_LDA(At, 1, 1); PG8_STAGE(PG8_SB(1, 0), b3, voffB); PG8_STAGE(PG8_SB(1, 1), b3 + hstep, voffB); PG8_STAGE(PG8_SA(1, 0), a3, voffA);
            PG8_WAIT_V(8); PG8_WAIT_L(0); PG8_BAR; PG8_MMA(1, 0, At, B0); PG8_MMA(1, 1, At, B1); PG8_BAR; PG8_SCHED;
        }
        if constexpr (ALIGN_EPI) { if (wr == 0) PG8_BAR; }
        E(acc, cur, wr, wc, fr, fq);
        if (!has_next) break;
#pragma unroll
        for (int a = 0; a < 2; ++a)
#pragma unroll
            for (int b = 0; b < 2; ++b)
#pragma unroll
                for (int m = 0; m < 4; ++m)
#pragma unroll
                    for (int n = 0; n < 2; ++n) acc[a][b][m][n] = (f32x4){0.f, 0.f, 0.f, 0.f};
        cur = nxt; cA = nA; cB = nB; ++ui;
        if constexpr (ALIGN_EPI) { if (wr == 1) PG8_BAR; }
    }
    PG8_WAIT_V(0);
    if constexpr (!ALIGN_EPI) { if (wr == 0) PG8_BAR; }
    PG8_BAR;
#undef PG8_ABASE
#undef PG8_SA
#undef PG8_SB
#undef PG8_STAGE
#undef PG8_LDA
#undef PG8_LDB
#undef PG8_MMA
#undef PG8_WAIT_V
#undef PG8_WAIT_L
#undef PG8_BAR
#undef PG8_SCHED
}
}

struct Args {
    const float* x; const float* norm_mix_g; const float* w_in; const float* conv_w; const float* a_log; const float* dt_bias;
    const float* gdn_norm_g; const float* fq_g; const float* fk_g; const float* f_bias; const float* w_pa; const float* w_pb;
    const float* w_out; const float* norm_mlp_g; const float* w_up; const float* w_dn;
    float* out; unsigned char* ws;
    int cg_seam; int pad;
};

template <int UNR = 32>
__device__ __forceinline__ void p0_transpose_item(const float* W, int K, int N, bf16_t* WT, int src_off, int dst_off, int ncols, LAS float* scr, int item, int lane, const float* kscale = nullptr  ) {
    const int nblk = ncols / 32, kb = item / nblk, nb = item % nblk, k0 = 64 * kb, n0 = 32 * nb;
#pragma unroll UNR
    for (int i = 0; i < 32; ++i) { const int kk = 2 * i + (lane >> 5); float w_ = W[(size_t)(k0 + kk) * N + src_off + n0 + (lane & 31)]; if (kscale) w_ *= kscale[k0 + kk]; scr[kk * 33 + (lane & 31)] = w_; }
    LDS_WAIT(); asm volatile("" ::: "memory");
    const int c = lane & 7;
#pragma unroll
    for (int j = 0; j < 4; ++j) { const int n = (lane >> 3) + 8 * j; const LAS float* s = scr + (8 * c) * 33 + n;
        u32x4 o; o.x = cvtpk(s[0 * 33], s[1 * 33]); o.y = cvtpk(s[2 * 33], s[3 * 33]); o.z = cvtpk(s[4 * 33], s[5 * 33]); o.w = cvtpk(s[6 * 33], s[7 * 33]);
        *(u32x4*)(WT + (size_t)(dst_off + n0 + n) * K + k0 + 8 * c) = o; }
    LDS_WAIT(); asm volatile("" ::: "memory");
}
__device__ __forceinline__ void rms_load(const float* xrow, int lane, f32x4 (&v)[4]) {
    const f32x4* xr = (const f32x4*)xrow + lane;
#pragma unroll
    for (int j = 0; j < 4; ++j) v[j] = xr[64 * j];
}
__device__ __forceinline__ void rms_finish(const float* g, bf16_t* orow, int lane, f32x4 (&v)[4]) {
    float s = 0.f;
#pragma unroll
    for (int j = 0; j < 4; ++j) s += (v[j].x * v[j].x + v[j].y * v[j].y) + (v[j].z * v[j].z + v[j].w * v[j].w);
    const float rstd = __builtin_amdgcn_rsqf(wave_sum(s) * (1.f / DM) + EPS);
    u32x2* o8 = (u32x2*)orow + lane;
#pragma unroll
    for (int j = 0; j < 4; ++j) { const f32x4 gg = ((const f32x4*)g)[lane + 64 * j]; v[j] = v[j] * rstd * gg; u32x2 w; w.x = cvtpk(v[j].x, v[j].y); w.y = cvtpk(v[j].z, v[j].w); o8[64 * j] = w; }
}

namespace fa {
constexpr int D = 128, LD = HD  , LDO = DM  , NW = 8, QBLK = 32, KVBLK = 64, QB = NW * QBLK;
constexpr int SHM_V = KVBLK * D * 2, SHM_K = KVBLK * D * 2;
constexpr int LDS_WS = 2 * SHM_V + 2 * SHM_K;
constexpr int LDS_CB = LDS_WS + NW * 64 * 4;
constexpr int LDS_TOTAL = LDS_CB + 2 * 2048 * 4;
constexpr float SCALE = SM_SCALE;
constexpr float THR = 40.f;
#define KSWZ(row, colB) ((row) * 256 + ((colB) ^ (((row) & 7) << 4)))
#define SBAR() __builtin_amdgcn_sched_barrier(0)
__device__ __forceinline__ int v_st(int k, int c) { const int kk = (k & ~0xC) | ((k & 4) << 1) | ((k & 8) >> 1); return ((kk >> 3) * 4 + (c >> 5)) * 512 + ((kk & 7) * 32 + (c & 31)) * 2; }
__device__ __forceinline__ int v_rd_base(int lane) { return ((lane & 3) << 3) | (((lane >> 2) & 3) << 6) | (((lane >> 4) & 1) << 5) | (((lane >> 5) & 1) << 8); }
constexpr int v_rd_off(int d0, int ks, int half) { return d0 * 512 + ks * 4096 + half * 2048; }
__device__ __forceinline__ int crow(int r, int hi) { return (r & 3) + 8 * (r >> 2) + 4 * hi; }
__device__ __forceinline__ bf16x8 load8(const bf16_t* p) { return *reinterpret_cast<const bf16x8*>(p); }
__device__ __forceinline__ void mask_tile(f32x16& p0, f32x16& p1, int dq) {
    const float NEG = -__builtin_inff();
#pragma unroll
    for (int r = 0; r < 16; ++r) { const int c = (r & 3) + 8 * (r >> 2); if (dq - c < 0) p0[r] = NEG; if (dq - c - 32 < 0) p1[r] = NEG; }
}
__device__ __forceinline__ void bias_tile(f32x16& p0, f32x16& p1, const float* cb) {
    { const f32x4 a0 = *(const f32x4*)(cb), a1 = *(const f32x4*)(cb + 8), a2 = *(const f32x4*)(cb + 16), a3 = *(const f32x4*)(cb + 24);
#pragma unroll
      for (int i = 0; i < 4; ++i) { p0[i] += a0[i]; p0[4 + i] += a1[i]; p0[8 + i] += a2[i]; p0[12 + i] += a3[i]; } }
    asm volatile("" ::: "memory");
    { const f32x4 a0 = *(const f32x4*)(cb + 32), a1 = *(const f32x4*)(cb + 40), a2 = *(const f32x4*)(cb + 48), a3 = *(const f32x4*)(cb + 56);
#pragma unroll
      for (int i = 0; i < 4; ++i) { p1[i] += a0[i]; p1[4 + i] += a1[i]; p1[8 + i] += a2[i]; p1[12 + i] += a3[i]; } }
    asm volatile("" ::: "memory");
}
__device__ __forceinline__ void partialSM(f32x16& p0, f32x16& p1, float& m_reg, float& mn, float& alpha) {
    float pmax = p0[0]; for (int r = 1; r < 16; ++r) pmax = fmaxf(pmax, p0[r]); for (int r = 0; r < 16; ++r) pmax = fmaxf(pmax, p1[r]);
    { auto rr = __builtin_amdgcn_permlane32_swap(__float_as_uint(pmax), __float_as_uint(pmax), false, false);
      pmax = fmaxf(__uint_as_float(rr[0]), __uint_as_float(rr[1])); }
    constexpr float C2 = 1.4426950408889634f * SCALE;
    if (__builtin_expect(__all((pmax - m_reg) * SCALE <= THR), 1)) { mn = m_reg; alpha = 1.f; }
    else { mn = fmaxf(m_reg, pmax); alpha = __builtin_amdgcn_exp2f((m_reg - mn) * C2); m_reg = mn; }
    const float mnL = -mn * C2;
    for (int r = 0; r < 16; ++r) p0[r] = fmaf(p0[r], C2, mnL); for (int r = 0; r < 16; ++r) p1[r] = fmaf(p1[r], C2, mnL);
    for (int r = 0; r < 16; ++r) p0[r] = __builtin_amdgcn_exp2f(p0[r]);
}
__device__ __forceinline__ void finishSM(f32x16& p0, f32x16& p1, float alpha, float& l_reg, bf16x8& pa0, bf16x8& pa1, bf16x8& pa2, bf16x8& pa3) {
    for (int r = 0; r < 16; ++r) p1[r] = __builtin_amdgcn_exp2f(p1[r]);
    float ps = 0; for (int r = 0; r < 16; ++r) ps += p0[r]; for (int r = 0; r < 16; ++r) ps += p1[r];
    { auto rr = __builtin_amdgcn_permlane32_swap(__float_as_uint(ps), __float_as_uint(ps), false, false);
      ps = __uint_as_float(rr[0]) + __uint_as_float(rr[1]); }
    l_reg = l_reg * alpha + ps;
#define PK4(P, B_, OUT) do { unsigned a0 = cvtpk(P[B_+0], P[B_+1]), a1 = cvtpk(P[B_+2], P[B_+3]);                          \
        unsigned b0 = cvtpk(P[B_+4], P[B_+5]), b1 = cvtpk(P[B_+6], P[B_+7]);                                             \
        auto r0 = __builtin_amdgcn_permlane32_swap(a0, b0, false, false); auto r1 = __builtin_amdgcn_permlane32_swap(a1, b1, false, false); \
        u32x4 w = {r0[0], r1[0], r0[1], r1[1]}; OUT = *reinterpret_cast<bf16x8*>(&w); } while (0)
    PK4(p0, 0, pa0); PK4(p0, 8, pa1); PK4(p1, 0, pa2); PK4(p1, 8, pa3);
#undef PK4
}
template <int KB>
__device__ __forceinline__ void qkt(f32x16& p0, f32x16& p1, const char* K_lds, int r32, int hi, const bf16x8* qr, const float* cb  ) {
#pragma unroll
    for (int g = 0; g < 4; ++g) { const f32x4 a = *(const f32x4*)(cb + 8 * g), b = *(const f32x4*)(cb + 32 + 8 * g);
#pragma unroll
        for (int i = 0; i < 4; ++i) { p0[4 * g + i] = a[i]; p1[4 * g + i] = b[i]; } }
    const char* kb[4];
#pragma unroll
    for (int dd = 0; dd < 4; ++dd) kb[dd] = K_lds + KB * SHM_K + KSWZ(r32, (dd * 16 + hi * 8) * 2);
    __builtin_amdgcn_s_setprio(1);
#pragma unroll
    for (int d0 = 0; d0 < 8; ++d0) { const char* a = kb[d0 & 3] + (d0 >> 2) * 128;
        bf16x8 b0 = *reinterpret_cast<const bf16x8*>(a);
        bf16x8 b1 = *reinterpret_cast<const bf16x8*>(a + 32 * 256);
        p0 = __builtin_amdgcn_mfma_f32_32x32x16_bf16(b0, qr[d0], p0, 0, 0, 0);
        p1 = __builtin_amdgcn_mfma_f32_32x32x16_bf16(b1, qr[d0], p1, 0, 0, 0); }
    __builtin_amdgcn_s_setprio(0);
}
template <int VB>
__device__ __forceinline__ void pv_tile(f32x16* o, int vb0, bf16x8 pa0, bf16x8 pa1, bf16x8 pa2, bf16x8 pa3) {
#define TRRD(dst, off) asm volatile("ds_read_b64_tr_b16 %0, %1 offset:%2" : "=&v"(dst) : "v"(vb0), "i"(off) : "memory")
#define PV_D0(d0) do { s16x4 l0, l1, l2, l3, h0, h1, h2, h3; constexpr int b_ = VB * SHM_V + v_rd_off(d0, 0, 0); \
        TRRD(l0, b_); TRRD(h0, b_ + 2048); TRRD(l1, b_ + 4096); TRRD(h1, b_ + 6144); TRRD(l2, b_ + 8192); TRRD(h2, b_ + 10240); TRRD(l3, b_ + 12288); TRRD(h3, b_ + 14336); \
        asm volatile("s_waitcnt lgkmcnt(0)" ::: "memory"); SBAR();   \
        o[d0] = __builtin_amdgcn_mfma_f32_32x32x16_bf16(pa0, (bf16x8){l0[0], l0[1], l0[2], l0[3], h0[0], h0[1], h0[2], h0[3]}, o[d0], 0, 0, 0);   \
        o[d0] = __builtin_amdgcn_mfma_f32_32x32x16_bf16(pa1, (bf16x8){l1[0], l1[1], l1[2], l1[3], h1[0], h1[1], h1[2], h1[3]}, o[d0], 0, 0, 0);   \
        o[d0] = __builtin_amdgcn_mfma_f32_32x32x16_bf16(pa2, (bf16x8){l2[0], l2[1], l2[2], l2[3], h2[0], h2[1], h2[2], h2[3]}, o[d0], 0, 0, 0);   \
        o[d0] = __builtin_amdgcn_mfma_f32_32x32x16_bf16(pa3, (bf16x8){l3[0], l3[1], l3[2], l3[3], h3[0], h3[1], h3[2], h3[3]}, o[d0], 0, 0, 0); } while (0)
    __builtin_amdgcn_s_setprio(1); PV_D0(0); PV_D0(1); PV_D0(2); PV_D0(3); __builtin_amdgcn_s_setprio(0);
#undef PV_D0
#undef TRRD
}
struct BlockRef { const bf16_t* Q; const bf16_t* K; const bf16_t* V; bf16_t* O; int P0; };
struct NextCtx { unsigned* ctr; int* s_item; const bf16_t* Qb; const bf16_t* Kb; const bf16_t* Vb; bf16_t* Ob; const float* cb; int nit; int xcd; };
__device__ __forceinline__ int decode_item(int li, int xcd) {
    if (li < 8) return li * 8 + xcd;
    if (li < 72) { const int k = li - 8, qb = 7 - (k >> 3), bh = (k & 7) * 8 + xcd; return 64 + (7 - qb) * 64 + bh; }
    return 2048 + (li - 72) * 8 + xcd;
}
__device__ __forceinline__ BlockRef item_ref(const NextCtx& nc, int it) {
    const int k = it - 64, qb = 7 - (k >> 6), bh = k & 63; const size_t rb = (size_t)(bh >> 3) * SEQ; const int h = bh & 7;
    BlockRef r; const size_t hb = (size_t)bh * SEQ * HD;
    r.Q = nc.Qb + hb + (size_t)qb * 256 * HD; r.K = nc.Kb + hb; r.V = nc.Vb + hb; r.O = nc.Ob + (rb + qb * 256) * DM + h * HD; r.P0 = qb * 256; return r;
}
__device__ __forceinline__ const float* item_cb(const NextCtx& nc, int it) { return nc.cb + (size_t)((it - 64) & 63) * SEQ; }
struct Seam { bf16x8 qr[8]; bf16x8 st_v0, st_v1, st_k0, st_k1; };
#define ROW(p, k0, rr) ((p) + (size_t)((k0) + (rr)) * LD + sc)
#define VMW() asm volatile("s_waitcnt vmcnt(0)" ::: "memory")
#define VMWN(n) asm volatile("s_waitcnt vmcnt(%0)" :: "i"(n) : "memory")
#define SLOAD_H(Kp, Vp, k0) do { S.st_v0 = load8(ROW(Vp, k0, sr)); S.st_v1 = load8(ROW(Vp, k0, 32 + sr));              \
                         S.st_k0 = load8(ROW(Kp, k0, sr)); S.st_k1 = load8(ROW(Kp, k0, 32 + sr)); } while (0)
#define SWRITE_HK(bf) do { *(bf16x8*)(K_lds + (bf) * SHM_K + kws) = S.st_k0; *(bf16x8*)(K_lds + (bf) * SHM_K + kws + 32 * 256) = S.st_k1; } while (0)
#define SWRITE_HV(bf) do { *(bf16x8*)(V_lds + (bf) * SHM_V + vst0) = S.st_v0; *(bf16x8*)(V_lds + (bf) * SHM_V + vst1) = S.st_v1; } while (0)
#define SWRITE_H(bf) do { SWRITE_HV(bf); SWRITE_HK(bf); } while (0)
__device__ __forceinline__ void attn_prime(const BlockRef& cur, char* lds, Seam& S) {
    const int tid = otid(), wid = __builtin_amdgcn_readfirstlane(tid >> 6), lane = tid & 63, r32 = lane & 31, hi = lane >> 5;
    const int sr = tid >> 4, sc = (tid & 15) * 8, kws = KSWZ(sr, sc * 2); char* K_lds = lds + 2 * SHM_V;
    for (int d0 = 0; d0 < 8; ++d0) S.qr[d0] = load8(cur.Q + (size_t)(wid * QBLK + r32) * LD + d0 * 16 + hi * 8);
    SLOAD_H(cur.K, cur.V, 0); VMW(); SWRITE_HK(0);
    __syncthreads();
}
__device__ __forceinline__ void attn_block(const BlockRef& cur, char* lds, Seam& S, int cbsel, const NextCtx& nc, int& itn  ) {
    const int tid = otid(), wid = __builtin_amdgcn_readfirstlane(tid >> 6), lane = tid & 63, r32 = lane & 31, hi = lane >> 5;
    const int NT = (cur.P0 + QB) / KVBLK;
    const int qlo = cur.P0 + wid * QBLK, qm = qlo + r32 - 4 * hi;
    char* V_lds = lds; char* K_lds = lds + 2 * SHM_V;
    float* ws = (float*)(lds + LDS_WS) + wid * 64; float* li_l = ws, * al_l = ws + 32;
    const float* cbl = (const float*)(lds + LDS_CB + cbsel * 8192) + 4 * hi;
    float m_reg = -1e30f, l_reg = 0; f32x16 o[4] = {};
    const int sr = tid >> 4, sc = (tid & 15) * 8, vst0 = v_st(sr, sc), vst1 = v_st(32 + sr, sc), kws = KSWZ(sr, sc * 2);
    const int vb0 = (int)(uintptr_t)V_lds + v_rd_base(lane);
    const bf16_t* Kh = cur.K; const bf16_t* Vh = cur.V;
#define RESC(a) do { if (__any((a) < 1.f)) { if (hi == 0) al_l[r32] = (a); asm volatile("s_waitcnt lgkmcnt(0)" ::: "memory");              \
                     for (int d_ = 0; d_ < 4; ++d_) for (int r = 0; r < 16; ++r) o[d_][r] *= al_l[crow(r, hi)]; } } while (0)
#define KBASE(t) ((t) * KVBLK)
#define MASKT(P0_, P1_, t) do { const int kb_ = KBASE(t); if (kb_ + KVBLK - 1 > qlo) mask_tile(P0_, P1_, qm - kb_); } while (0)
    constexpr int NQL = 8;
#define SEAM_K0() do { VMWN(NQL); SWRITE_HK(0); SBAR(); } while (0)
    f32x16 pA0, pA1, pB0, pB1; float mnA, mnB, alA, alB; bf16x8 pa0, pa1, pa2, pa3;
    SWRITE_HV(0); SBAR();
    if (NT > 1) { SLOAD_H(Kh, Vh, KBASE(1)); }
    SBAR(); qkt<0>(pA0, pA1, K_lds, r32, hi, S.qr, cbl);
    MASKT(pA0, pA1, 0); partialSM(pA0, pA1, m_reg, mnA, alA);
    if (NT > 1) { VMW(); SWRITE_H(1); }
    __syncthreads();
#define HALF_STEP(PX0, PX1, mnX, alX, PY0, PY1, alY, t, KB, VB, SB) do {                                                      \
        SBAR(); qkt<KB>(PX0, PX1, K_lds, r32, hi, S.qr, cbl + KBASE(t));                                             \
        finishSM(PY0, PY1, alY, l_reg, pa0, pa1, pa2, pa3); SBAR();                                                           \
        if ((t) + 1 < NT) { SLOAD_H(Kh, Vh, KBASE((t) + 1)); SBAR(); }                                               \
        pv_tile<VB>(o, vb0, pa0, pa1, pa2, pa3); MASKT(PX0, PX1, (t)); partialSM(PX0, PX1, m_reg, mnX, alX);                                        \
        __syncthreads();                                                                                                      \
        if ((t) + 1 < NT) { VMW(); SWRITE_H(SB); }                                                                          \
        RESC(alX); __syncthreads(); } while (0)
    for (int t = 1; t + 1 < NT; t += 2) {
        HALF_STEP(pB0, pB1, mnB, alB, pA0, pA1, alA, t, 1, 0, 0);
        HALF_STEP(pA0, pA1, mnA, alA, pB0, pB1, alB, t + 1, 0, 1, 1);
    }
    if (tid == 0) *nc.s_item = (int)atomicAdd(nc.ctr, 1u);
    __syncthreads(); itn = __builtin_amdgcn_readfirstlane(decode_item(*nc.s_item, nc.xcd)); __syncthreads();
    const bool more = itn >= 64 && itn < nc.nit;
    const BlockRef nxt = more ? item_ref(nc, itn) : cur; const float* nxt_cb = item_cb(nc, more ? itn : 64);
    if (more && wid * 256 < nxt.P0 + QB)
        __builtin_amdgcn_global_load_lds((const unsigned*)(nxt_cb + tid * 4), (LAS unsigned*)(LAS char*)(lds + LDS_CB + (cbsel ^ 1) * 8192 + wid * 1024), 16, 0, 0);
    const bool even = (NT & 1) == 0;
    if (even) { SBAR(); qkt<1>(pB0, pB1, K_lds, r32, hi, S.qr, cbl + KBASE(NT - 1)); SBAR(); }
    SLOAD_H(nxt.K, nxt.V, 0); SBAR();
#pragma unroll
    for (int d0 = 0; d0 < 8; ++d0) S.qr[d0] = load8(nxt.Q + (size_t)(wid * QBLK + r32) * LD + d0 * 16 + hi * 8);
    SBAR();
    finishSM(pA0, pA1, alA, l_reg, pa0, pa1, pa2, pa3); SBAR();
    pv_tile<0>(o, vb0, pa0, pa1, pa2, pa3);
    if (even) { MASKT(pB0, pB1, NT - 1); partialSM(pB0, pB1, m_reg, mnB, alB); __syncthreads(); RESC(alB);
        finishSM(pB0, pB1, alB, l_reg, pa0, pa1, pa2, pa3); SBAR(); pv_tile<1>(o, vb0, pa0, pa1, pa2, pa3); }
    SBAR(); SEAM_K0();
    if (hi == 0) li_l[r32] = l_reg; asm volatile("s_waitcnt lgkmcnt(0)" ::: "memory");
    float rli[16];
#pragma unroll
    for (int r = 0; r < 16; ++r) rli[r] = __builtin_amdgcn_rcpf(li_l[crow(r, hi)]);
    bf16_t* Ow = cur.O + (size_t)(wid * QBLK) * LDO;
#pragma unroll
    for (int r = 0; r < 16; ++r) { const int orow = crow(r, hi);
#pragma unroll
        for (int d0 = 0; d0 < 4; ++d0) { const float v = o[d0][r] * rli[r];
            const float vn = __shfl_xor(v, 1);
            if ((r32 & 1) == 0) *(unsigned*)(Ow + (size_t)orow * LDO + d0 * 32 + r32) = cvtpk(v, vn); } }
    __syncthreads();
#undef RESC
#undef KBASE
#undef MASKT
#undef SEAM_K0
#undef HALF_STEP
}
#undef ROW
#undef VMW
#undef VMWN
#undef SLOAD_H
#undef SWRITE_HK
#undef SWRITE_HV
#undef SWRITE_H
}

namespace gdn {
constexpr int RS = 136;
constexpr int TS = 72;
constexpr int AS = 68;
constexpr int L_RAW = 0;
constexpr int L_KBT = 0, L_VBT = 18432;
constexpr int L_QR = 54784, L_KR = 72192;
constexpr int L_A = 89600;
constexpr int L_TB = 107008;
constexpr int L_G = 116224, L_BETA = 116480;
constexpr int L_SSQ = 116736;
constexpr int L_WC = 126976;
constexpr int L_AB = 120832, L_TT = 123392, XS = 40;
__device__ __forceinline__ int crow(int r, int hi) { return (r & 3) + 8 * (r >> 2) + 4 * hi; }

__device__ __forceinline__ void raw_load(u32x4 (&rv)[7], int uidx, int tid, const bf16_t* gq, const bf16_t* gk, const bf16_t* gv) {
    const int h = uidx & 7, n = (uidx >> 3) & 31, bl = uidx >> 8; const int t0 = n * 64; const size_t rowb = (size_t)bl * SEQ;
#pragma unroll
    for (int k = 0; k < 7; ++k) { const int idx = tid + 512 * k;
        const int ten = idx / (67 * 16), rem = idx - ten * (67 * 16), row = rem >> 4, seg = rem & 15; const int t = t0 - 3 + row;
        const bf16_t* src = ten == 0 ? gq : (ten == 1 ? gk : gv);
        rv[k] = (u32x4){0u, 0u, 0u, 0u};
        if (idx < 3 * 67 * 16 && t >= 0) rv[k] = *(const u32x4*)(src + (rowb + t) * DM + h * HD + seg * 8); }
}
__device__ __forceinline__ void intra_unit(unsigned char* lds, int uidx, int unext, u32x4 (&rv)[7], int& hprev, int half, const bf16_t* gq, const bf16_t* gk, const bf16_t* gv, const float* small,
                           const float* conv_w, const float* a_log, const float* dt_bias, unsigned char* io, float* decg) {
    const int tid = otid(), lane = tid & 63, wid = __builtin_amdgcn_readfirstlane(tid >> 6), r32 = lane & 31, hi = lane >> 5;
    const int h = uidx & 7, n = (uidx >> 3) & 31, bl = uidx >> 8;
    const int t0 = n * 64; const size_t rowb = (size_t)bl * SEQ;
    const int ch = (bl * NH + h) * NCH + n;
    unsigned char* iob = io + (size_t)ch * IO_STRIDE;
    bf16_t* RAW = (bf16_t*)(lds + L_RAW);
    float* GS = (float*)(lds + L_G); float* BS = (float*)(lds + L_BETA); float* SSQ = (float*)(lds + L_SSQ);
    {
#pragma unroll
        for (int k = 0; k < 7; ++k) { const int idx = tid + 512 * k;
            const int ten = idx / (67 * 16), rem = idx - ten * (67 * 16), row = rem >> 4, seg = rem & 15;
            if (idx < 3 * 67 * 16) *(u32x4*)(RAW + (ten * 67 + row) * RS + seg * 8) = rv[k]; }
    }
    if (h != hprev) {
        float* WC = (float*)(lds + L_WC);
#pragma unroll
        for (int k = 0; k < 3; ++k) { const int j = tid + 512 * k, ten = j >> 9, tap = (j >> 7) & 3, d = j & 127; WC[j] = conv_w[(size_t)tap * 3072 + ten * 1024 + h * HD + d]; }
        hprev = h; }
    if (tid < 64) {
        const size_t grow = (size_t)half * MH + rowb + t0 + tid;
        const float ga = small[grow * 24 + h], gb = small[grow * 24 + 8 + h];
        const float xs = ga + dt_bias[h]; const float sp = xs > 20.f ? xs : log1pf(__expf(xs));
        float g = -__expf(a_log[h]) * sp;
#pragma unroll
        for (int o = 1; o < 64; o <<= 1) { const float up = __shfl_up(g, o); if (lane >= o) g += up; }
        GS[tid] = g; BS[tid] = sigmoidf_(gb);
    }
    LBAR();
    float yq[2][8], yk[2][8], yv[2][8]; float sq = 0.f, sk = 0.f;
#pragma unroll
    for (int bi = 0; bi < 2; ++bi) { const int d0 = (wid + 8 * bi) * 8;
#pragma unroll
        for (int ten = 0; ten < 3; ++ten) { float a[8];
#pragma unroll
            for (int i = 0; i < 8; ++i) a[i] = 0.f;
#pragma unroll
            for (int tap = 0; tap < 4; ++tap) { const u32x4 xr = *(const u32x4*)(RAW + (ten * 67 + lane + tap) * RS + d0);
                const float* wp = (const float*)(lds + L_WC) + (ten * 4 + tap) * 128 + d0; const f32x4 w0 = *(const f32x4*)wp, w1 = *(const f32x4*)(wp + 4);
                a[0] += w0[0] * bflo(xr.x); a[1] += w0[1] * bfhi(xr.x); a[2] += w0[2] * bflo(xr.y); a[3] += w0[3] * bfhi(xr.y);
                a[4] += w1[0] * bflo(xr.z); a[5] += w1[1] * bfhi(xr.z); a[6] += w1[2] * bflo(xr.w); a[7] += w1[3] * bfhi(xr.w); }
#pragma unroll
            for (int i = 0; i < 8; ++i) { const float y = siluf_(a[i]); if (ten == 0) { yq[bi][i] = y; sq += y * y; } else if (ten == 1) { yk[bi][i] = y; sk += y * y; } else yv[bi][i] = y; } } }
    SSQ[wid * 64 + lane] = sq; SSQ[512 + wid * 64 + lane] = sk;
    LBAR();
    {
        float tq = 0.f, tk = 0.f;
#pragma unroll
        for (int w = 0; w < 8; ++w) { tq += SSQ[w * 64 + lane]; tk += SSQ[512 + w * 64 + lane]; }
        const float rq = SM_SCALE * __builtin_amdgcn_rsqf(tq + EPS), rk = __builtin_amdgcn_rsqf(tk + EPS);
        const float G = GS[lane], beta = BS[lane], Gl = GS[63];
        const float eG = __expf(G), ekd = __expf(Gl - G), bE = beta * eG;
        bf16_t* QR = (bf16_t*)(lds + L_QR); bf16_t* KR = (bf16_t*)(lds + L_KR); bf16_t* KBT = (bf16_t*)(lds + L_KBT); bf16_t* VBT = (bf16_t*)(lds + L_VBT);
        bf16_t* gQd = (bf16_t*)(iob + IO_QD); bf16_t* gKdT = (bf16_t*)(iob + IO_KDT);
#pragma unroll
        for (int bi = 0; bi < 2; ++bi) { const int d0 = (wid + 8 * bi) * 8; float qn[8], kn[8];
#pragma unroll
            for (int i = 0; i < 8; ++i) { qn[i] = yq[bi][i] * rq; kn[i] = yk[bi][i] * rk; }
            u32x4 w;
            w.x = cvtpk(qn[0], qn[1]); w.y = cvtpk(qn[2], qn[3]); w.z = cvtpk(qn[4], qn[5]); w.w = cvtpk(qn[6], qn[7]); *(u32x4*)(QR + lane * RS + d0) = w;
            w.x = cvtpk(kn[0], kn[1]); w.y = cvtpk(kn[2], kn[3]); w.z = cvtpk(kn[4], kn[5]); w.w = cvtpk(kn[6], kn[7]); *(u32x4*)(KR + lane * RS + d0) = w;
            w.x = cvtpk(qn[0] * eG, qn[1] * eG); w.y = cvtpk(qn[2] * eG, qn[3] * eG); w.z = cvtpk(qn[4] * eG, qn[5] * eG); w.w = cvtpk(qn[6] * eG, qn[7] * eG);
            *(u32x4*)(gQd + lane * HD + d0) = w;
#pragma unroll
            for (int i = 0; i < 8; ++i) { KBT[(d0 + i) * TS + lane] = f2bf(kn[i] * bE); VBT[(d0 + i) * TS + lane] = f2bf(yv[bi][i] * beta); gKdT[(d0 + i) * 64 + lane] = f2bf(kn[i] * ekd); } }
        if (tid == 0) decg[ch] = __expf(Gl);
    }
    LBAR();
    {
        const int type = wid >> 2, it = (wid >> 1) & 1, jt = wid & 1;
        bf16_t* gAt = (bf16_t*)(iob + IO_AT); float* Af = (float*)(lds + L_A);
        const int j = 32 * jt + r32; const float Gj = GS[j];
        if (it == 0 && jt == 1) {
            if (type == 1) {
#pragma unroll
                for (int r = 0; r < 16; ++r) gAt[(crow(r, hi)) * 64 + j] = 0;
            }
        } else {
            const bf16_t* Ab = (const bf16_t*)(lds + (type ? L_QR : L_KR)) + (32 * it + r32) * RS + 8 * hi;
            const bf16_t* Bb = (const bf16_t*)(lds + L_KR) + (32 * jt + r32) * RS + 8 * hi;
            f32x16 acc = {};
#pragma unroll
            for (int s = 0; s < 8; ++s) acc = __builtin_amdgcn_mfma_f32_32x32x16_bf16(*(const bf16x8*)(Ab + 16 * s), *(const bf16x8*)(Bb + 16 * s), acc, 0, 0, 0);
            f32x4 Gr[4], Br[4];
#pragma unroll
            for (int g = 0; g < 4; ++g) { Gr[g] = *(const f32x4*)(GS + 32 * it + 8 * g + 4 * hi); Br[g] = *(const f32x4*)(BS + 32 * it + 8 * g + 4 * hi); }
            if (type == 0) {
#pragma unroll
                for (int r = 0; r < 16; ++r) { const int i = 32 * it + crow(r, hi); const float e_ = __expf(fminf(Gr[r >> 2][r & 3] - Gj, 0.f));
                    const float v_ = (i > j) ? Br[r >> 2][r & 3] * acc[r] * e_ : 0.f;
                    if (it == 1 && jt == 0) ((bf16_t*)(lds + L_AB))[(i - 32) * XS + j] = f2bf(v_); else Af[i * AS + j] = v_; }
            } else {
#pragma unroll
                for (int r = 0; r < 16; ++r) { const int i = 32 * it + crow(r, hi); const float e_ = __expf(fminf(Gr[r >> 2][r & 3] - Gj, 0.f));
                    gAt[i * 64 + j] = f2bf((i >= j) ? acc[r] * e_ : 0.f); }
            }
        }
    }
    LBAR();
    if (wid == 0) {
        const int c = lane & 31, hb = lane >> 5;
        LAS const float* Af = (LAS const float*)(lds + L_A) + (hb * 32) * AS + hb * 32;
        LAS bf16_t* TB = (LAS bf16_t*)(lds + L_TB) + (hb * 32) * TS + hb * 32 + c;
        asm volatile("" : "+v"(Af)); asm volatile("" : "+v"(TB));
        float t[32];
        f32x4 rowbuf[2][8];
        t[0] = (c == 0) ? 1.f : 0.f; TB[0] = f2bf(t[0]);
        rowbuf[1][0] = *(LAS const f32x4*)(Af + 1 * AS);
#pragma unroll
        for (int i = 1; i < 32; ++i) {
            if (i + 1 < 32) {
#pragma unroll
                for (int j4 = 0; j4 < (i + 4) / 4; ++j4) rowbuf[(i + 1) & 1][j4] = *(LAS const f32x4*)(Af + (i + 1) * AS + 4 * j4);
            }
            float s0 = (i == c) ? 1.f : 0.f, s1 = 0.f;
            asm volatile("" : "+v"(s0), "+v"(s1) :: "memory");
#pragma unroll
            for (int j4 = 0; j4 < (i + 3) / 4; ++j4) { const f32x4 a = rowbuf[i & 1][j4];
#pragma unroll
                for (int q = 0; q < 4; ++q) if (4 * j4 + q < i) { if (j4 & 1) s1 -= a[q] * t[4 * j4 + q]; else s0 -= a[q] * t[4 * j4 + q]; } }
            const float sv = s0 + s1;
            t[i] = sv; TB[i * TS] = f2bf(sv);
        }
        bf16_t* TT = (bf16_t*)(lds + L_TT); const bf16_t* AB = (const bf16_t*)(lds + L_AB);
        if (hb == 0) {
#pragma unroll
            for (int q = 0; q < 4; ++q) { u32x4 w; w.x = cvtpk(t[8 * q], t[8 * q + 1]); w.y = cvtpk(t[8 * q + 2], t[8 * q + 3]); w.z = cvtpk(t[8 * q + 4], t[8 * q + 5]); w.w = cvtpk(t[8 * q + 6], t[8 * q + 7]);
                *(u32x4*)(TT + c * XS + 8 * q) = w; }
        }
        asm volatile("s_waitcnt lgkmcnt(0)" ::: "memory");
        f32x16 Mx = {};
#pragma unroll
        for (int s2 = 0; s2 < 2; ++s2) Mx = __builtin_amdgcn_mfma_f32_32x32x16_bf16(*(const bf16x8*)(AB + c * XS + 16 * s2 + 8 * hb), *(const bf16x8*)(TT + c * XS + 16 * s2 + 8 * hb), Mx, 0, 0, 0);
        f32x16 Rx = {};
        const bf16_t* T22 = (const bf16_t*)(lds + L_TB) + (32 + c) * TS + 32 + 4 * hb;
#pragma unroll
        for (int s2 = 0; s2 < 2; ++s2) {
            u32x4 w = {cvtpk(Mx[8 * s2], Mx[8 * s2 + 1]), cvtpk(Mx[8 * s2 + 2], Mx[8 * s2 + 3]), cvtpk(Mx[8 * s2 + 4], Mx[8 * s2 + 5]), cvtpk(Mx[8 * s2 + 6], Mx[8 * s2 + 7])};
            const u32x2 a0 = *(const u32x2*)(T22 + 16 * s2), a1 = *(const u32x2*)(T22 + 16 * s2 + 8); u32x4 av = {a0.x, a0.y, a1.x, a1.y};
            Rx = __builtin_amdgcn_mfma_f32_32x32x16_bf16(__builtin_bit_cast(bf16x8, av), __builtin_bit_cast(bf16x8, w), Rx, 0, 0, 0); }
        bf16_t* T21 = (bf16_t*)(lds + L_TB) + 32 * TS + c;
#pragma unroll
        for (int r = 0; r < 16; ++r) T21[crow(r, hb) * TS] = f2bf(-Rx[r]);
        raw_load(rv, unext, tid, gq, gk, gv);
    } else {
        raw_load(rv, unext, tid, gq, gk, gv);
    }
    LBAR();
    {
        const bf16_t* TB = (const bf16_t*)(lds + L_TB);
        bf16_t* gUT = (bf16_t*)(iob + IO_UT); bf16_t* gWn = (bf16_t*)(iob + IO_WN);
#pragma unroll
        for (int qi = 0; qi < 2; ++qi) { const int q = wid * 2 + qi, type = q >> 3, it = (q >> 2) & 1, et = q & 3;
            const bf16_t* Ab = TB + (32 * it + r32) * TS + 8 * hi;
            const bf16_t* Bb = (const bf16_t*)(lds + (type ? L_KBT : L_VBT)) + (32 * et + r32) * TS + 8 * hi;
            f32x16 acc = {};
            const int ns = it ? 4 : 2;
            for (int s = 0; s < ns; ++s) acc = __builtin_amdgcn_mfma_f32_32x32x16_bf16(*(const bf16x8*)(Ab + 16 * s), *(const bf16x8*)(Bb + 16 * s), acc, 0, 0, 0);
            const int e = 32 * et + r32;
            if (type == 0) {
#pragma unroll
                for (int g = 0; g < 4; ++g) { u32x2 w; w.x = cvtpk(acc[4 * g], acc[4 * g + 1]); w.y = cvtpk(acc[4 * g + 2], acc[4 * g + 3]);
                    *(u32x2*)(gUT + e * 64 + 32 * it + 8 * g + 4 * hi) = w; }
            } else {
#pragma unroll
                for (int r = 0; r < 16; ++r) gWn[(32 * it + crow(r, hi)) * HD + e] = f2bf(-acc[r]);
            } }
    }
    LBAR();
}

constexpr int SB_WN = 0, SB_QD = 17408, SB_KDT = 34816, SB_AT = 53248, SB_SIZE = 62464;
__device__ __forceinline__ bf16x8 packb(f32x4 a, f32x4 b) { u32x4 w = {cvtpk(a[0], a[1]), cvtpk(a[2], a[3]), cvtpk(b[0], b[1]), cvtpk(b[2], b[3])}; return __builtin_bit_cast(bf16x8, w); }
__device__ __forceinline__ bf16x8 afrag(const bf16_t* p) { return *(const bf16x8*)p; }
__device__ void scan_unit(unsigned char* lds, int bh, const unsigned char* io, const float* decg, bf16_t* oa  , const bf16_t* gz, const float* gng) {
    const int tid = otid(), lane = tid & 63, wid = __builtin_amdgcn_readfirstlane(tid >> 6), fr = lane & 15, fq = lane >> 4;
    const int bl = bh >> 3, h = bh & 7;
    const unsigned char* iob = io + (size_t)bh * NCH * IO_STRIDE;
    u32x4 stA[7], stB[7];
#define SC_LOAD(st, nn) do { const unsigned char* b_ = iob + (size_t)(nn) * IO_STRIDE; \
        st[0] = *(const u32x4*)(b_ + IO_WN + tid * 16); st[1] = *(const u32x4*)(b_ + IO_WN + 8192 + tid * 16); \
        st[2] = *(const u32x4*)(b_ + IO_QD + tid * 16); st[3] = *(const u32x4*)(b_ + IO_QD + 8192 + tid * 16); \
        st[4] = *(const u32x4*)(b_ + IO_KDT + tid * 16); st[5] = *(const u32x4*)(b_ + IO_KDT + 8192 + tid * 16); \
        st[6] = *(const u32x4*)(b_ + IO_AT + tid * 16); } while (0)
#define SC_PERM(j) (32 * ((j) >> 2) + 16 * ((j) & 1) + 4 * (((j) >> 1) & 1))
#define SC_W16(base, rowstride, row, j, v) do { unsigned char* d_ = (base) + ((row) * (rowstride) + SC_PERM(j)) * 2; *(u32x2*)d_ = (u32x2){(v).x, (v).y}; *(u32x2*)(d_ + 16) = (u32x2){(v).z, (v).w}; } while (0)
#define SC_WRITE(st, bufi) do { unsigned char* l_ = lds + (bufi) * SB_SIZE; \
        { const int p = tid; SC_W16(l_ + SB_WN, RS, p >> 4, p & 15, st[0]); SC_W16(l_ + SB_QD, RS, p >> 4, p & 15, st[2]); \
          SC_W16(l_ + SB_KDT, TS, p >> 3, p & 7, st[4]); SC_W16(l_ + SB_AT, TS, p >> 3, p & 7, st[6]); } \
        { const int p = tid + 512; SC_W16(l_ + SB_WN, RS, p >> 4, p & 15, st[1]); SC_W16(l_ + SB_QD, RS, p >> 4, p & 15, st[3]); \
          SC_W16(l_ + SB_KDT, TS, p >> 3, p & 7, st[5]); } } while (0)
    f32x4 S[8];
#pragma unroll
    for (int i = 0; i < 8; ++i) S[i] = (f32x4){0.f, 0.f, 0.f, 0.f};
    SC_LOAD(stA, 0); SC_WRITE(stA, 0); SC_LOAD(stB, 1); SC_LOAD(stA, 2);
    const int e = 16 * wid + fr;
    constexpr int SB_OT = 2 * SB_SIZE, OT_SIZE = 64 * RS * 2;
    const int nrow = tid >> 3, ncs = (tid & 7) * 16;
    float* gnl = (float*)(lds + SB_OT + 2 * OT_SIZE);
    if (tid < 128) gnl[tid] = gng[tid];
    const int zoff = (bl * SEQ + nrow) * DM + h * HD + ncs;
    u32x4 zc0 = {0u, 0u, 0u, 0u}, zc1 = zc0, zn0 = zc0, zn1 = zc0;
#define SC_NORM(nn, Z0, Z1) do { const bf16_t* ot_ = (const bf16_t*)(lds + SB_OT + ((nn) & 1) * OT_SIZE) + nrow * RS + ncs; \
        const u32x4 x0 = *(const u32x4*)ot_, x1 = *(const u32x4*)(ot_ + 8); \
        float f[16] = {bflo(x0.x), bfhi(x0.x), bflo(x0.y), bfhi(x0.y), bflo(x0.z), bfhi(x0.z), bflo(x0.w), bfhi(x0.w), \
                       bflo(x1.x), bfhi(x1.x), bflo(x1.y), bfhi(x1.y), bflo(x1.z), bfhi(x1.z), bflo(x1.w), bfhi(x1.w)}; \
        float z[16] = {bflo(Z0.x), bfhi(Z0.x), bflo(Z0.y), bfhi(Z0.y), bflo(Z0.z), bfhi(Z0.z), bflo(Z0.w), bfhi(Z0.w), \
                       bflo(Z1.x), bfhi(Z1.x), bflo(Z1.y), bfhi(Z1.y), bflo(Z1.z), bfhi(Z1.z), bflo(Z1.w), bfhi(Z1.w)}; \
        float ss = 0.f; _Pragma("unroll") for (int i = 0; i < 16; ++i) ss += f[i] * f[i]; \
        ss += __shfl_xor(ss, 1); ss += __shfl_xor(ss, 2); ss += __shfl_xor(ss, 4); \
        const float rstd = __builtin_amdgcn_rsqf(ss * (1.f / HD) + EPS); \
        _Pragma("unroll") for (int q = 0; q < 4; ++q) { const f32x4 g4 = *(const f32x4*)(gnl + ncs + 4 * q); \
            _Pragma("unroll") for (int i = 0; i < 4; ++i) f[4 * q + i] = f[4 * q + i] * rstd * g4[i] * siluf_(z[4 * q + i]); } \
        u32x4 y0, y1; y0.x = cvtpk(f[0], f[1]); y0.y = cvtpk(f[2], f[3]); y0.z = cvtpk(f[4], f[5]); y0.w = cvtpk(f[6], f[7]); \
        y1.x = cvtpk(f[8], f[9]); y1.y = cvtpk(f[10], f[11]); y1.z = cvtpk(f[12], f[13]); y1.w = cvtpk(f[14], f[15]); \
        bf16_t* op_ = oa + (zoff + (nn) * 64 * DM); *(u32x4*)op_ = y0; *(u32x4*)(op_ + 8) = y1; } while (0)
    u32x2 un[4]; float decn;
    { const bf16_t* ut = (const bf16_t*)(iob + IO_UT) + e * 64 + 4 * fq;
#pragma unroll
      for (int tt = 0; tt < 4; ++tt) un[tt] = *(const u32x2*)(ut + 16 * tt);
      decn = decg[bh * NCH]; }
    LBAR();
    for (int n2 = 0; n2 < NCH; n2 += 2) {
#pragma unroll
    for (int par = 0; par < 2; ++par) { const int n = n2 + par;
        const unsigned char* L = lds + (n & 1) * SB_SIZE;
        f32x4 vn[4], o[4]; const float dec = decn;
#pragma unroll
        for (int tt = 0; tt < 4; ++tt) { vn[tt] = (f32x4){bflo(un[tt].x), bfhi(un[tt].x), bflo(un[tt].y), bfhi(un[tt].y)}; o[tt] = (f32x4){0.f, 0.f, 0.f, 0.f}; }
        if (n + 1 < NCH) {
            const bf16_t* ut = (const bf16_t*)(iob + (size_t)(n + 1) * IO_STRIDE + IO_UT) + e * 64 + 4 * fq;
#pragma unroll
            for (int tt = 0; tt < 4; ++tt) un[tt] = *(const u32x2*)(ut + 16 * tt);
            decn = decg[bh * NCH + n + 1]; }
        zn0 = *(const u32x4*)(gz + (zoff + n * 64 * DM)); zn1 = *(const u32x4*)(gz + (zoff + n * 64 * DM + 8));
        if (n > 0) SC_NORM(n - 1, zc0, zc1);
        zc0 = zn0; zc1 = zn1;
        bf16x8 Sb[4];
#pragma unroll
        for (int k = 0; k < 4; ++k) Sb[k] = packb(S[2 * k], S[2 * k + 1]);
        const bf16_t* Wn = (const bf16_t*)(L + SB_WN) + fr * RS + 8 * fq; const bf16_t* Qd = (const bf16_t*)(L + SB_QD) + fr * RS + 8 * fq;
        const bf16_t* At = (const bf16_t*)(L + SB_AT) + fr * TS + 8 * fq; const bf16_t* Kd = (const bf16_t*)(L + SB_KDT) + fr * TS + 8 * fq;
        bf16x8 fa[2][4];
#define SC_LD4(buf, p0, p1, p2, p3) do { fa[buf][0] = afrag(p0); fa[buf][1] = afrag(p1); fa[buf][2] = afrag(p2); fa[buf][3] = afrag(p3); } while (0)
#define SC_LDG4(g, buf) do { \
        if ((g) < 8) { const int tt_ = (g) >> 1, k0_ = 2 * ((g) & 1); SC_LD4(buf, Wn + 16 * tt_ * RS + 32 * k0_, Qd + 16 * tt_ * RS + 32 * k0_, Wn + 16 * tt_ * RS + 32 * (k0_ + 1), Qd + 16 * tt_ * RS + 32 * (k0_ + 1)); } \
        else if ((g) < 10) { const int t0_ = 2 * ((g) - 8); SC_LD4(buf, At + 16 * t0_ * TS, At + 16 * (t0_ + 1) * TS, At + 16 * t0_ * TS + 32, At + 16 * (t0_ + 1) * TS + 32); } \
        else { const int d0_ = 2 * ((g) - 10); SC_LD4(buf, Kd + 16 * d0_ * TS, Kd + 16 * (d0_ + 1) * TS, Kd + 16 * d0_ * TS + 32, Kd + 16 * (d0_ + 1) * TS + 32); } } while (0)
#define SC_MMA(acc, A, B) acc = __builtin_amdgcn_mfma_f32_16x16x32_bf16(A, B, acc, 0, 0, 0)
        SC_LDG4(0, 0);
#pragma unroll
        for (int g = 0; g < 8; ++g) { const int tt = g >> 1, k0 = 2 * (g & 1);
            SC_LDG4(g + 1, (g + 1) & 1);
            asm volatile("" : "+v"(vn[tt]), "+v"(o[tt]) :: "memory");
            SC_MMA(vn[tt], fa[g & 1][0], Sb[k0]); SC_MMA(o[tt], fa[g & 1][1], Sb[k0]); SC_MMA(vn[tt], fa[g & 1][2], Sb[k0 + 1]); SC_MMA(o[tt], fa[g & 1][3], Sb[k0 + 1]); }
        bf16x8 vb[2];
        vb[0] = packb(vn[0], vn[1]); vb[1] = packb(vn[2], vn[3]);
#pragma unroll
        for (int g = 8; g < 10; ++g) { const int t0 = 2 * (g - 8);
            SC_LDG4(g + 1, (g + 1) & 1);
            asm volatile("" : "+v"(o[t0]), "+v"(o[t0 + 1]) :: "memory");
            SC_MMA(o[t0], fa[g & 1][0], vb[0]); SC_MMA(o[t0 + 1], fa[g & 1][1], vb[0]); SC_MMA(o[t0], fa[g & 1][2], vb[1]); SC_MMA(o[t0 + 1], fa[g & 1][3], vb[1]); }
#pragma unroll
        for (int dt = 0; dt < 8; ++dt) S[dt] = S[dt] * dec;
#pragma unroll
        for (int g = 10; g < 14; ++g) { const int d0 = 2 * (g - 10);
            if (g < 13) SC_LDG4(g + 1, (g + 1) & 1);
            asm volatile("" : "+v"(S[d0]), "+v"(S[d0 + 1]) :: "memory");
            SC_MMA(S[d0], fa[g & 1][0], vb[0]); SC_MMA(S[d0 + 1], fa[g & 1][1], vb[0]); SC_MMA(S[d0], fa[g & 1][2], vb[1]); SC_MMA(S[d0 + 1], fa[g & 1][3], vb[1]); }
#undef SC_LDG4
#undef SC_LD4
#undef SC_MMA
        { bf16_t* ot = (bf16_t*)(lds + SB_OT + (n & 1) * OT_SIZE) + (4 * fq) * RS + e;
#pragma unroll
          for (int tt = 0; tt < 4; ++tt)
#pragma unroll
              for (int i = 0; i < 4; ++i) ot[(16 * tt + i) * RS] = f2bf(o[tt][i]); }
        if (n + 1 < NCH) { if (par == 0) SC_WRITE(stB, 1); else SC_WRITE(stA, 0); }
        if (n + 3 < NCH) { if (par == 0) SC_LOAD(stB, n + 3); else SC_LOAD(stA, n + 3); }
        LBAR();
    } }
    SC_NORM(NCH - 1, zc0, zc1);
    LBAR();
#undef SC_NORM
#undef SC_LOAD
#undef SC_WRITE
}
}

#define XB_TMO      128
#define XB_XCNT(j)  (256  + 64 * (j))
#define XB_XSUB(j)  (1280 + 64 * (j))
#define XB_XGEN(j)  (2304 + 64 * (j))
#define XB_TOP      3328
#define XB_TOPGEN   3392
#define XCD_BAR_WORDS 3456
#define XB_SPIN_CAP (1u << 22)
__device__ __forceinline__ unsigned xb_ld(unsigned* p)              { return __hip_atomic_load(p, __ATOMIC_RELAXED, __HIP_MEMORY_SCOPE_AGENT); }
__device__ __forceinline__ unsigned xb_add(unsigned* p, unsigned v) { return __hip_atomic_fetch_add(p, v, __ATOMIC_RELAXED, __HIP_MEMORY_SCOPE_AGENT); }
__device__ __forceinline__ unsigned xb_xcc_id() { return (unsigned)__builtin_amdgcn_s_getreg((3 << 11) | 20) & 0xFu; }
#define XB_SPIN(cond, bar) do { unsigned _sp = 0; while (cond) { __builtin_amdgcn_s_sleep(1); \
    if ((++_sp & 255u) == 0u) { if (xb_ld(&(bar)[XB_TMO])) break; if (_sp > XB_SPIN_CAP) { atomicAdd(&(bar)[XB_TMO], 1u); break; } } } } while (0)
struct XcdBarrier { unsigned* bar; unsigned x; volatile LAS unsigned* st; };
__device__ __forceinline__ XcdBarrier xcd_barrier_post(unsigned* bar, volatile LAS unsigned* st) {
    XcdBarrier b; b.bar = bar; b.x = xb_xcc_id(); b.st = st;
    if (threadIdx.x == 0) (void)xb_add(&bar[XB_XCNT(b.x)], 1u);
    return b;
}
__device__ __forceinline__ void xcd_barrier_complete(unsigned* bar, unsigned x, unsigned& nloc, unsigned& nx) {
    const unsigned G = gridDim.x * gridDim.y * gridDim.z;
    unsigned sum, cnt, mine, sp = 0u;
    for (;;) {
        sum = 0u; cnt = 0u; mine = 0u;
#pragma unroll
        for (unsigned j = 0; j < 16; ++j) { const unsigned c = xb_ld(&bar[XB_XCNT(j)]); sum += c; cnt += (c > 0u) ? 1u : 0u; mine = (j == x) ? c : mine; }
        if (sum == G) break;
        __builtin_amdgcn_s_sleep(1);
        if ((++sp & 255u) == 0u) { if (xb_ld(&bar[XB_TMO])) break; if (sp > XB_SPIN_CAP) { atomicAdd(&bar[XB_TMO], 1u); break; } }
    }
    nloc = mine > 0u ? mine : 1u; nx = cnt > 0u ? cnt : 1u;
}
__device__ __forceinline__ void xcd_barrier(const XcdBarrier& b) {
    asm volatile("s_waitcnt vmcnt(0)" ::: "memory");
    __syncthreads();
    if (threadIdx.x == 0) {
        unsigned* bar = b.bar;
        __builtin_amdgcn_s_waitcnt(0);
        unsigned nloc = b.st[0], nx = b.st[1];
        if (nloc == 0u) { xcd_barrier_complete(bar, b.x, nloc, nx); b.st[0] = nloc; b.st[1] = nx; }
        const unsigned old = xb_add(&bar[XB_XSUB(b.x)], 1u);
        const unsigned gen = old / nloc;
        if (old + 1u == (gen + 1u) * nloc) {
            __builtin_amdgcn_fence(__ATOMIC_RELEASE, "agent");
            asm volatile("s_waitcnt vmcnt(0)" ::: "memory");
            const unsigned og = xb_add(&bar[XB_TOP], 1u);
            const unsigned tg = og / nx;
            if (og + 1u == (tg + 1u) * nx) xb_add(&bar[XB_TOPGEN], 1u);
            else XB_SPIN(xb_ld(&bar[XB_TOPGEN]) == tg, bar);
            __builtin_amdgcn_fence(__ATOMIC_ACQUIRE, "agent");
            xb_add(&bar[XB_XGEN(b.x)], 1u);
            asm volatile("s_waitcnt vmcnt(0)" ::: "memory");
        } else {
            XB_SPIN(xb_ld(&bar[XB_XGEN(b.x)]) == gen, bar);
            __builtin_amdgcn_fence(__ATOMIC_ACQUIRE, "agent");
            asm volatile("s_waitcnt vmcnt(0)" ::: "memory");
        }
    }
    __syncthreads();
}

__global__ void __launch_bounds__(512, 2) hybrid_fwd(Args a) {
    extern __shared__ __attribute__((aligned(16))) unsigned char lds_raw[];
    cg::grid_group grid = cg::this_grid();
    LAS unsigned char* ldsL = (LAS unsigned char*)lds_raw;
    const int G = gridDim.x, NGW = G * 8;
    { volatile LAS unsigned* z = (volatile LAS unsigned*)(ldsL + LDS_BYTES - 32); if (threadIdx.x < 2) z[threadIdx.x] = 0u; }
    __syncthreads();
    const XcdBarrier xbar = xcd_barrier_post((unsigned*)(a.ws + WS_CTL) + 4096, (volatile LAS unsigned*)(ldsL + LDS_BYTES - 32));
#define WSB() ({ size_t z_ = 0; asm volatile("" : "+s"(z_)); a.ws + z_; })

#if !defined(OFF_P0)
    for (int rep0 = 0; rep0 < 1 + DUP_P0; ++rep0) {
        const int tid = otid(), lane = tid & 63, wid = __builtin_amdgcn_readfirstlane(tid >> 6), gw = blockIdx.x * 8 + wid; (void)tid; (void)lane; (void)gw;
        LAS float* scr = (LAS float*)(ldsL + wid * 16384);
        constexpr int I_A = 16 * 128, I_B = 16 * 96, I_C = 16 * 64;
        constexpr int NITEMS = I_A + I_B + I_C;
        for (int it = gw; it < NITEMS; it += NGW) {
            int r = it;
            if (r < I_A) { p0_transpose_item(a.w_in, DM, NIN, ((bf16_t*)(WSB() + WS_WIN)), 0, 0, 4096, scr, r, lane); continue; } r -= I_A;
            if (r < I_B) { p0_transpose_item(a.w_in, DM, NIN, ((bf16_t*)(WSB() + WS_WIN)), 4112, 4096, 3072, scr, r, lane); continue; } r -= I_B;
            p0_transpose_item(a.w_in, DM, NIN, ((bf16_t*)(WSB() + WS_WIN)), 7192, 7168, 2048, scr, r, lane);
        }
        __syncthreads();
        float* wsm = (float*)lds_raw;
        {
            f32x4 wv[2][6]; const float gk[2] = {a.norm_mix_g[tid], a.norm_mix_g[tid + 512]};
#pragma unroll
            for (int kk = 0; kk < 2; ++kk) { const float* wr_ = a.w_in + (size_t)(tid + 512 * kk) * NIN;
#pragma unroll
                for (int q = 0; q < 4; ++q) wv[kk][q] = *(const f32x4*)(wr_ + 4096 + 4 * q);
                wv[kk][4] = *(const f32x4*)(wr_ + 7184); wv[kk][5] = *(const f32x4*)(wr_ + 7188); }
#pragma unroll
            for (int kk = 0; kk < 2; ++kk)
#pragma unroll
                for (int q = 0; q < 6; ++q)
#pragma unroll
                    for (int i = 0; i < 4; ++i) wsm[(4 * q + i) * 1024 + tid + 512 * kk] = wv[kk][q][i] * gk[kk];
        }
        __syncthreads();
        if (wid < 4) {
            typedef float f32x16v __attribute__((ext_vector_type(16)));
            const int i = lane & 31, kk = lane >> 5;
            float* rsl = (float*)(lds_raw + 98304) + wid * 32;
            for (int tile = blockIdx.x * 4 + wid; tile < MTOT / 32; tile += G * 4) {
                const float* xr = a.x + (size_t)(32 * tile + i) * DM + kk * 4;
                const float* wl = wsm + (i < 24 ? i : 0) * 1024 + kk * 4;
                f32x16v acc = {}; float ssq = 0.f;
#pragma unroll 16
                for (int c = 0; c < 128; ++c) { const f32x4 av = *(const f32x4*)(xr + c * 8); const f32x4 bv = *(const f32x4*)(wl + c * 8);
                    ssq += (av.x * av.x + av.y * av.y) + (av.z * av.z + av.w * av.w);
                    acc = __builtin_amdgcn_mfma_f32_32x32x2f32(av.x, bv.x, acc, 0, 0, 0); acc = __builtin_amdgcn_mfma_f32_32x32x2f32(av.y, bv.y, acc, 0, 0, 0);
                    acc = __builtin_amdgcn_mfma_f32_32x32x2f32(av.z, bv.z, acc, 0, 0, 0); acc = __builtin_amdgcn_mfma_f32_32x32x2f32(av.w, bv.w, acc, 0, 0, 0); }
                { auto rr = __builtin_amdgcn_permlane32_swap(__float_as_uint(ssq), __float_as_uint(ssq), false, false); ssq = __uint_as_float(rr[0]) + __uint_as_float(rr[1]); }
                if (kk == 0) rsl[i] = __builtin_amdgcn_rsqf(ssq * (1.f / DM) + EPS);
                asm volatile("s_waitcnt lgkmcnt(0)" ::: "memory");
                if (i < 24) {
#pragma unroll
                    for (int g = 0; g < 4; ++g) { const f32x4 r4 = *(const f32x4*)(rsl + 8 * g + 4 * kk);
#pragma unroll
                        for (int q = 0; q < 4; ++q) ((float*)(WSB() + WS_SMALL))[(size_t)(32 * tile + 8 * g + 4 * kk + q) * 24 + i] = acc[4 * g + q] * r4[q]; } }
                asm volatile("s_waitcnt lgkmcnt(0)" ::: "memory");
            }
        } else {
            const int gw4 = blockIdx.x * 4 + (wid - 4), NGW4 = G * 4;
            for (int m = gw4; m < MTOT; m += 2 * NGW4) {
                f32x4 va[4], vb[4];
                rms_load(a.x + (size_t)m * DM, lane, va); rms_load(a.x + (size_t)(m + NGW4) * DM, lane, vb);
                rms_finish(a.norm_mix_g, ((bf16_t*)((unsigned char*)a.out + 64 * MiB)) + (size_t)m * DM, lane, va); rms_finish(a.norm_mix_g, ((bf16_t*)((unsigned char*)a.out + 64 * MiB)) + (size_t)(m + NGW4) * DM, lane, vb);
            }
        }
        __syncthreads();
    }
#endif
    if (a.cg_seam) grid.sync(); else GSYNC();

    for (int half = 0; half < NHALF; ++half) {
        const size_t roff = (size_t)half * MH;
#if !defined(OFF_G1)
        {
            pg8::Gemm g{((bf16_t*)((unsigned char*)a.out + 64 * MiB)) + roff * DM, ((bf16_t*)(WSB() + WS_WIN)), MH, NPROJ, DM}; pg8::StaticOrder S; S.init(MH, NPROJ, G, (int)blockIdx.x);
            pg8::EpiBf16<0> E{((bf16_t*)(WSB() + WS_PROJ + (size_t)(0) * GRP)), DM, DM, GRP / 2, 4, 7, 4, 6, a.fq_g, a.fk_g, (LAS float*)(ldsL + 131072), nullptr};
            for (int rep = 0; rep < 1 + DUP_G1; ++rep)
            pg8::gemm_phase<pg8::EpiBf16<0>, pg8::StaticOrder, true>(ldsL, g, S, E);
        }
#endif
        GSYNC();
        {
#if !defined(OFF_PREPAB)
            const int tid = otid(), lane = tid & 63, wid = __builtin_amdgcn_readfirstlane(tid >> 6), gw = blockIdx.x * 8 + wid; (void)tid; (void)lane; (void)gw;
            for (int bh = gw; bh < BH * NH; bh += NGW) { const int bl = bh >> 3, h = bh & 7; const float fb = a.f_bias[h];
                const float* sp = ((float*)(WSB() + WS_SMALL)) + (roff + (size_t)bl * SEQ + lane * 32) * 24 + 16 + h; float loc[32]; float run = 0.f;
#pragma unroll
                for (int i = 0; i < 32; ++i) { const float xv = sp[(size_t)i * 24] + fb; const float ls = fminf(xv, 0.f) - log1pf(__expf(-fabsf(xv))); run += ls; loc[i] = run; }
                float inc = run;
#pragma unroll
                for (int o = 1; o < 64; o <<= 1) { const float up = __shfl_up(inc, o); if (lane >= o) inc += up; }
                const float excl = inc - run; float* cp = ((float*)(WSB() + WS_CB)) + ((size_t)(half * BH * NH + bh)) * SEQ + lane * 32;
#pragma unroll
                for (int i = 0; i < 32; ++i) cp[i] = -(excl + loc[i]) * (1.f / SM_SCALE); }
#endif
#ifndef NO_INTRA
            { u32x4 rv[7]; int hprev = -1; const int NU = BH * NH * NCH;
              gdn::raw_load(rv, blockIdx.x, tid, ((bf16_t*)(WSB() + WS_PROJ + (size_t)(0) * GRP)), ((bf16_t*)(WSB() + WS_PROJ + (size_t)(1) * GRP)), ((bf16_t*)(WSB() + WS_PROJ + (size_t)(2) * GRP)));
              for (int u = blockIdx.x; u < NU; u += G)
                  gdn::intra_unit(lds_raw, u, u + G < NU ? u + G : u  , rv, hprev, half, ((bf16_t*)(WSB() + WS_PROJ + (size_t)(0) * GRP)), ((bf16_t*)(WSB() + WS_PROJ + (size_t)(1) * GRP)), ((bf16_t*)(WSB() + WS_PROJ + (size_t)(2) * GRP)), ((float*)(WSB() + WS_SMALL)), a.conv_w, a.a_log, a.dt_bias, (WSB() + WS_IO), ((float*)(WSB() + WS_DEC))); }
#endif
        }
        GSYNC();
        {
            const int tid = otid(), lane = tid & 63, wid = __builtin_amdgcn_readfirstlane(tid >> 6), gw = blockIdx.x * 8 + wid; (void)tid; (void)lane; (void)gw;
            LAS int* s_item = (LAS int*)(ldsL + LDS_BYTES - 64);
            for (int rep = 0; rep < 1 + (DUP_SA ? 1 : 0); ++rep) {
            const int xcd = blockIdx.x & 7;
            unsigned* ctr = ((unsigned*)(WSB() + WS_CTL)) + 64 * (8 + (half * 2 + rep) * 8 + xcd);
            if (rep) xcd_barrier(xbar);
            const int NIT = (rep && DUP_SA == 2) ? 64 : 64 + 512;
            fa::Seam S = {}; bool primed = false; int cbsel = 0;
            fa::NextCtx nc; nc.ctr = ctr; nc.s_item = (int*)(lds_raw + LDS_BYTES - 64); nc.Qb = ((bf16_t*)(WSB() + WS_PROJ + (size_t)(4) * GRP)); nc.Kb = ((bf16_t*)(WSB() + WS_PROJ + (size_t)(5) * GRP)); nc.Vb = ((bf16_t*)(WSB() + WS_PROJ + (size_t)(6) * GRP)); nc.Ob = ((bf16_t*)(WSB() + WS_PROJ + 2 * GRP)); nc.cb = ((float*)(WSB() + WS_CB)) + (size_t)(half * BH * NH) * SEQ; nc.nit = NIT; nc.xcd = xcd;
#define Q_FETCH(dst) do { if (tid == 0) *s_item = (int)atomicAdd(ctr, 1u); __syncthreads(); dst = __builtin_amdgcn_readfirstlane(fa::decode_item(*s_item, xcd)); __syncthreads(); } while (0)
            const int NTR = (rep ? 0 : (half == 0 ? 192 : 512));
            int it; Q_FETCH(it);
            while (it < NIT) {
#ifndef NO_SCAN
                if (it < 64) { gdn::scan_unit(lds_raw, it, (WSB() + WS_IO), ((float*)(WSB() + WS_DEC)), ((bf16_t*)(WSB() + WS_PROJ)), ((bf16_t*)(WSB() + WS_PROJ + (size_t)(3) * GRP)), a.gdn_norm_g); primed = false; S = fa::Seam{}; Q_FETCH(it); continue; }
#endif
#ifndef NO_ATTN
                {
                    const fa::BlockRef cur = fa::item_ref(nc, it);
                    if (!primed) {
                        float* cbl = (float*)(lds_raw + fa::LDS_CB + cbsel * 8192);
                        if (tid * 4 < cur.P0 + 256) *(f32x4*)(cbl + tid * 4) = *(const f32x4*)(fa::item_cb(nc, it) + tid * 4);
                        fa::attn_prime(cur, (char*)lds_raw, S); }
                    int itn;
                    fa::attn_block(cur, (char*)lds_raw, S, cbsel, nc, itn);
                    primed = itn >= 64 && itn < NIT; if (primed) cbsel ^= 1;
                    it = itn;
                }
#else
                Q_FETCH(it);
#endif
            }
            while (it >= 2048 && it < 2048 + NTR) {
                const int witem = (it - 2048) * 8 + wid; LAS float* scr = (LAS float*)(ldsL + wid * 16384);
                if (half == 0) { const int m = witem >> 9, r = witem & 511; p0_transpose_item<8>(m == 0 ? a.w_pa : (m == 1 ? a.w_pb : a.w_out), DM, DM, m == 0 ? ((bf16_t*)(WSB() + WS_WPA)) : (m == 1 ? ((bf16_t*)(WSB() + WS_WPB)) : ((bf16_t*)(WSB() + WS_WOUT))), 0, 0, DM, scr, r, lane); }
                else { if (witem < 2048) p0_transpose_item<8>(a.w_up, DM, DFF, ((bf16_t*)(WSB() + WS_WUP)), 0, 0, DFF, scr, witem, lane, a.norm_mlp_g); else p0_transpose_item<8>(a.w_dn, DFF, DM, ((bf16_t*)(WSB() + WS_WDN)), 0, 0, DM, scr, witem - 2048, lane); }
                __syncthreads(); Q_FETCH(it); }
#undef Q_FETCH
#undef A_REF
#undef A_CB
            }
        }
#if 0
        {
            const int tid = otid(), lane = tid & 63, wid = __builtin_amdgcn_readfirstlane(tid >> 6), gw = blockIdx.x * 8 + wid; (void)tid; (void)lane; (void)gw;
            for (int m = gw; m < MH; m += 2 * NGW) {
                u32x4 xin[2][4];
#pragma unroll
                for (int q = 0; q < 2; ++q) { const bf16_t* p = ((bf16_t*)(WSB() + WS_PROJ)) + (size_t)(m + q * NGW) * DM + lane * 16; const bf16_t* zp = ((bf16_t*)(WSB() + WS_PROJ + (size_t)(3) * GRP)) + (size_t)(m + q * NGW) * DM + lane * 16;
                    xin[q][0] = *(const u32x4*)p; xin[q][1] = *(const u32x4*)(p + 8); xin[q][2] = *(const u32x4*)zp; xin[q][3] = *(const u32x4*)(zp + 8); }
#pragma unroll
                for (int q = 0; q < 2; ++q) { bf16_t* p = ((bf16_t*)(WSB() + WS_PROJ)) + (size_t)(m + q * NGW) * DM + lane * 16; const float* gg = a.gdn_norm_g + (lane & 7) * 16;
                    const u32x4 x0 = xin[q][0], x1 = xin[q][1], z0 = xin[q][2], z1 = xin[q][3];
                    float f[16] = {bflo(x0.x), bfhi(x0.x), bflo(x0.y), bfhi(x0.y), bflo(x0.z), bfhi(x0.z), bflo(x0.w), bfhi(x0.w),
                                   bflo(x1.x), bfhi(x1.x), bflo(x1.y), bfhi(x1.y), bflo(x1.z), bfhi(x1.z), bflo(x1.w), bfhi(x1.w)};
                    float z[16] = {bflo(z0.x), bfhi(z0.x), bflo(z0.y), bfhi(z0.y), bflo(z0.z), bfhi(z0.z), bflo(z0.w), bfhi(z0.w),
                                   bflo(z1.x), bfhi(z1.x), bflo(z1.y), bfhi(z1.y), bflo(z1.z), bfhi(z1.z), bflo(z1.w), bfhi(z1.w)};
                    float s = 0.f;
#pragma unroll
                    for (int i = 0; i < 16; ++i) s += f[i] * f[i];
                    s += __shfl_xor(s, 1); s += __shfl_xor(s, 2); s += __shfl_xor(s, 4);
                    const float rstd = __builtin_amdgcn_rsqf(s * (1.f / HD) + EPS);
#pragma unroll
                    for (int i = 0; i < 16; ++i) f[i] = f[i] * rstd * gg[i] * siluf_(z[i]);
                    u32x4 y0, y1; y0.x = cvtpk(f[0], f[1]); y0.y = cvtpk(f[2], f[3]); y0.z = cvtpk(f[4], f[5]); y0.w = cvtpk(f[6], f[7]);
                    y1.x = cvtpk(f[8], f[9]); y1.y = cvtpk(f[10], f[11]); y1.z = cvtpk(f[12], f[13]); y1.w = cvtpk(f[14], f[15]);
                    *(u32x4*)p = y0; *(u32x4*)(p + 8) = y1; }
            }
        }
#endif
        GSYNC();
#if !defined(OFF_G2)
        {
            static_assert(WS_WPB == WS_WPA + (size_t)DM * DM * 2, "P_B's bf16 copy must follow P_A's: the second stage's B tiles are addressed as rows 1024.. of one [2048][1024] matrix");
            pg8::Gemm g{((bf16_t*)(WSB() + WS_PROJ)), ((bf16_t*)(WSB() + WS_WPA)), MH, DM, DM, (const bf16_t*)(WSB() + WS_PROJ + 2 * GRP), MH / 256};
            pg8::TwoStageOrder S; S.base.init(MH, DM, G, (int)blockIdx.x); S.dpm = MH / 256; S.dpn = DM / 256;
            pg8::EpiGate E{((bf16_t*)(WSB() + WS_PROJ + (size_t)(7) * GRP)), ((bf16_t*)(WSB() + WS_PROJ + (size_t)(8) * GRP)), (bf16_t*)(WSB() + (half == 0 ? WS_MG0 : WS_PROJ + 3 * GRP)), MH / 256, DM / 256};
            pg8::gemm_phase<pg8::EpiGate, pg8::TwoStageOrder, true>(ldsL, g, S, E);
        }
#endif
        GSYNC();
    }
#if !defined(OFF_G4)
    {
        pg8::Gemm g{(const bf16_t*)(WSB() + WS_MG0), ((bf16_t*)(WSB() + WS_WOUT)), MTOT, DM, DM, (const bf16_t*)(WSB() + WS_PROJ + 3 * GRP), MH / 256}; pg8::StaticOrder S; S.init(MTOT, DM, G, (int)blockIdx.x);
        pg8::EpiResF32<true> E{a.x, a.out, (bf16_t*)(WSB() + WS_HB), (float*)(WSB() + WS_HSS), (LAS float*)(ldsL + 131072)};
        for (int r4 = 0; r4 < 1 + DUP_G4; ++r4)
        pg8::gemm_phase<pg8::EpiResF32<true>, pg8::StaticOrder, true>(ldsL, g, S, E);
    }
#endif
    GSYNC();
    bf16_t* ACT = (bf16_t*)(WSB() + WS_ACT);
#if !defined(OFF_G5)
    {
        pg8::Gemm g{(const bf16_t*)(WSB() + WS_HB), ((bf16_t*)(WSB() + WS_WUP)), MTOT, DFF, DM}; pg8::StaticOrder S; S.init(MTOT, DFF, G, (int)blockIdx.x);
        pg8::EpiBf16<2> E{ACT, DFF, 0, 0, 0, 0, 0, 0, nullptr, nullptr, (LAS float*)(ldsL + 131072), (const float*)(WSB() + WS_HSS)};
        for (int r5 = 0; r5 < 1 + DUP_G5; ++r5)
        pg8::gemm_phase<pg8::EpiBf16<2>, pg8::StaticOrder, true>(ldsL, g, S, E);
    }
#endif
    GSYNC();
#if !defined(OFF_G6)
    {
        pg8::Gemm g{ACT, ((bf16_t*)(WSB() + WS_WDN)), MTOT, DM, DFF}; pg8::StaticOrder S; S.init(MTOT, DM, G, (int)blockIdx.x);
        pg8::EpiResF32<false> E{a.out, a.out, nullptr, nullptr, (LAS float*)(ldsL + 131072)};
        pg8::gemm_phase<pg8::EpiResF32<false>, pg8::StaticOrder, true>(ldsL, g, S, E);
    }
#endif
}

extern "C" void kernel_launch(void* const* d_in, const int* in_sizes, int n_in, void* d_out, int out_size, void* d_ws, size_t ws_size, hipStream_t stream) {
    static int grid = 0;
    if (grid == 0) {
        if (n_in != 16 || in_sizes[0] != MTOT * DM || out_size != MTOT * DM || ws_size < WS_END) {
            fprintf(stderr, "kernel_launch: unexpected shapes / workspace (n_in %d, in0 %d, out %d, ws %zu)\n", n_in, n_in > 0 ? in_sizes[0] : -1, out_size, ws_size); grid = -1; return; }
        int dev = 0, cus = 0, per_cu = 0;
        (void)hipGetDevice(&dev); (void)hipDeviceGetAttribute(&cus, hipDeviceAttributeMultiprocessorCount, dev);
        if (hipFuncSetAttribute((const void*)hybrid_fwd, hipFuncAttributeMaxDynamicSharedMemorySize, LDS_BYTES) != hipSuccess) { fprintf(stderr, "kernel_launch: hipFuncSetAttribute failed\n"); grid = -1; return; }
        if (hipOccupancyMaxActiveBlocksPerMultiprocessor(&per_cu, (const void*)hybrid_fwd, 512, LDS_BYTES) != hipSuccess || per_cu < 1) { fprintf(stderr, "kernel_launch: occupancy query says %d\n", per_cu); per_cu = 1; }
        (void)hipGetLastError();
        grid = cus * 1;
        if (grid <= 0) grid = 256;
    }
    if (grid < 0) return;
    (void)hipMemsetAsync((char*)d_ws + WS_CTL, 0, 65536, stream);
    Args a{};
    a.x = (const float*)d_in[0]; a.norm_mix_g = (const float*)d_in[1]; a.w_in = (const float*)d_in[2]; a.conv_w = (const float*)d_in[3];
    a.a_log = (const float*)d_in[4]; a.dt_bias = (const float*)d_in[5]; a.gdn_norm_g = (const float*)d_in[6]; a.fq_g = (const float*)d_in[7];
    a.fk_g = (const float*)d_in[8]; a.f_bias = (const float*)d_in[9]; a.w_pa = (const float*)d_in[10]; a.w_pb = (const float*)d_in[11];
    a.w_out = (const float*)d_in[12]; a.norm_mlp_g = (const float*)d_in[13]; a.w_up = (const float*)d_in[14]; a.w_dn = (const float*)d_in[15];
    a.out = (float*)d_out; a.ws = (unsigned char*)d_ws; a.cg_seam = 0; a.pad = 0;
    void* args[] = {&a};
    hipError_t e = hipLaunchCooperativeKernel((const void*)hybrid_fwd, dim3(grid), dim3(512), args, LDS_BYTES, stream);
    if (e != hipSuccess) fprintf(stderr, "kernel_launch: cooperative launch failed: %s (grid %d)\n", hipGetErrorString(e), grid);
}
```

```cpp
#include <hip/hip_runtime.h>
#include <hip/hip_bf16.h>
#include <hip/hip_cooperative_groups.h>
#include <cstdio>
#include <cstdint>
namespace cg = cooperative_groups;

#define LAS __attribute__((address_space(3)))
typedef unsigned short bf16_t;
typedef short bf16x8 __attribute__((ext_vector_type(8)));
typedef short s16x4 __attribute__((ext_vector_type(4)));
typedef float f32x4 __attribute__((ext_vector_type(4)));
typedef float f32x16 __attribute__((ext_vector_type(16)));
typedef float f32x2 __attribute__((ext_vector_type(2)));
typedef unsigned u32x4 __attribute__((ext_vector_type(4)));
typedef unsigned u32x2 __attribute__((ext_vector_type(2)));
typedef __bf16 bf16x2_t __attribute__((ext_vector_type(2)));

constexpr int BATCH = 16, SEQ = 2048, DM = 1024, NH = 8, HD = 128, DFF = 4096, NIN = 9240;
constexpr int MTOT = BATCH * SEQ;
constexpr int NHALF = 2, MH = MTOT / NHALF;
constexpr int BH = BATCH / NHALF;
constexpr int NPROJ = 9216;
constexpr float EPS = 1e-6f;
constexpr float SM_SCALE = 0.08838834764831845f;
constexpr int NCH = SEQ / 64;

constexpr size_t MiB = 1u << 20;
constexpr size_t WS_CTL = 0;
constexpr size_t WS_WIN = 1 * MiB;
constexpr size_t WS_WPA = 19 * MiB, WS_WPB = 21 * MiB, WS_WOUT = 23 * MiB, WS_WUP = 25 * MiB, WS_WDN = 33 * MiB;
constexpr size_t WS_SMALL = 41 * MiB;
constexpr size_t WS_CB = 44 * MiB;
constexpr size_t WS_DEC = 45 * MiB;
constexpr size_t WS_PROJ = 48 * MiB;
constexpr size_t GRP = 32 * MiB;
constexpr size_t WS_IO = 336 * MiB;
constexpr size_t WS_HSS = 45 * MiB + 65536;
constexpr size_t WS_MG0 = 480 * MiB;
constexpr size_t WS_HB = 176 * MiB;
constexpr size_t WS_ACT = 240 * MiB;
constexpr size_t WS_END = 512 * MiB;
constexpr size_t IO_STRIDE = 73728;
constexpr size_t IO_WN = 0, IO_QD = 16384, IO_KDT = 32768, IO_AT = 49152, IO_UT = 57344;
constexpr int LDS_BYTES = 163840;
#define DUP_SYNC 0
#define DUP_SA 0
#define DUP_INTRA 0
#define DUP_G1 0
#define DUP_P0 0
#define DUP_G4 0
#define DUP_G5 0
#define GSYNC() do { xcd_barrier(xbar); if (DUP_SYNC) xcd_barrier(xbar); } while (0)

__device__ __forceinline__ unsigned cvtpk(float lo, float hi) { f32x2 v = {lo, hi}; bf16x2_t b = __builtin_convertvector(v, bf16x2_t); return __builtin_bit_cast(unsigned, b); }
__device__ __forceinline__ float bflo(unsigned w) { return __uint_as_float(w << 16); }
__device__ __forceinline__ float bfhi(unsigned w) { return __uint_as_float(w & 0xffff0000u); }
__device__ __forceinline__ bf16_t f2bf(float f) { return (bf16_t)(cvtpk(f, 0.f) & 0xffffu); }
__device__ __forceinline__ float bf2f(bf16_t h) { return __uint_as_float(((unsigned)h) << 16); }
__device__ __forceinline__ float wave_sum(float v) {
#pragma unroll
    for (int o = 1; o < 64; o <<= 1) v += __shfl_xor(v, o);
    return v;
}
__device__ __forceinline__ float sigmoidf_(float x) { return __builtin_amdgcn_rcpf(1.f + __expf(-x)); }
__device__ __forceinline__ float siluf_(float x) { return x * __builtin_amdgcn_rcpf(1.f + __expf(-x)); }
__device__ __forceinline__ int otid() { int t = threadIdx.x; asm volatile("" : "+v"(t)); return t; }
#define LDS_WAIT() asm volatile("s_waitcnt lgkmcnt(0)" ::: "memory")
#define LBAR() do { asm volatile("s_waitcnt lgkmcnt(0)" ::: "memory"); __builtin_amdgcn_s_barrier(); asm volatile("" ::: "memory"); } while (0)

namespace pg8 {
constexpr int BM = 256, BK = 64, HALF = 128, HTB = HALF * BK * 2, STAGE_BYTES = 8 * HTB, NXCD = 8, WGM = 8;
__host__ __device__ __forceinline__ int lds_byte(int r, int c) { const int st = (r >> 4) * 2 + (c >> 5), rr = r & 15, cc = c & 31, ob = rr * 64 + cc * 2; return st * 1024 + (ob ^ (((ob >> 9) & 1) << 5)); }
__host__ __device__ __forceinline__ void stage_rc(int b, int& R, int& C) { const int st = b / 1024, sb = b % 1024, swz = sb ^ (((sb >> 9) & 1) << 5); R = (st >> 1) * 16 + swz / 64; C = (st & 1) * 32 + (swz % 64) / 2; }
__host__ __device__ __forceinline__ int perm32(int rho) { const int n = rho >> 4, i = rho & 15; return 8 * (i >> 2) + 4 * n + (i & 3); }
struct Unit { int pm, pn; };
struct Gemm { const bf16_t* A; const bf16_t* Bt; int M, N, K; const bf16_t* A1 = nullptr; int pm1 = 1 << 30; };
struct StaticOrder {
    int nM, nN, nwg, G, c;
    __host__ __device__ void init(int M, int N, int G_, int c_) { nM = M / BM; nN = N / BM; nwg = nM * nN; G = G_; c = c_; }
    __host__ __device__ bool next(int i, Unit& u) const {
        const long L = (long)i * G + c; if (L >= nwg) return false;
        int wgid = (int)L; { const int q = nwg / NXCD, r = nwg % NXCD, xcd = wgid % NXCD, off = wgid / NXCD; wgid = (xcd < r ? xcd * (q + 1) : r * (q + 1) + (xcd - r) * q) + off; }
        const int nig = WGM * nN, gid = wgid / nig, fm = gid * WGM, gsz = (nM - fm) < WGM ? (nM - fm) : WGM;
        u.pm = fm + ((wgid % nig) % gsz); u.pn = (wgid % nig) / gsz; return true;
    }
    __device__ __forceinline__ void a_ready(const Unit&) const {}
    __device__ __forceinline__ void done(const Unit&) const {}
};
struct TwoStageOrder {
    StaticOrder base; int dpm, dpn;
    __device__ bool next(int i, Unit& u) const { Unit b; if (!base.next(i >> 1, b)) return false; u.pm = b.pm + (i & 1) * dpm; u.pn = b.pn + (i & 1) * dpn; return true; }
    __device__ __forceinline__ void a_ready(const Unit&) const {}
    __device__ __forceinline__ void done(const Unit&) const {}
};
template <int ACT  > struct EpiBf16 {
    static constexpr bool PERM = true, AFTER_DRAIN = false;
    bf16_t* O; int ldc; int split_cols; size_t split_stride; int hm_lo, hm_hi;
    int nrm_lo, nrm_hi; const float* ng0; const float* ng1; LAS float* xl; const float* hss;
    __device__ __forceinline__ void operator()(const f32x4 (&acc)[2][2][4][2], const Unit& u, int wr, int wc, int fr, int fq) const {
        const int row0 = u.pm * BM + wr * 64 + fr; int colt = u.pn * BM; bf16_t* base = O; bool hm = false, nrm = false; const float* ng = ng0;
        if (split_cols) { const int t = colt / split_cols; base += (size_t)t * split_stride; colt -= t * split_cols; hm = t >= hm_lo && t < hm_hi; nrm = t >= nrm_lo && t < nrm_hi; if (t > nrm_lo) ng = ng1; }
        const int col0 = colt + wc * 32 + 8 * fq;
        f32x4 g0 = {1.f, 1.f, 1.f, 1.f}, g1 = g0;
        if (ACT == 0 && nrm) {
#pragma unroll
            for (int ai = 0; ai < 2; ++ai)
#pragma unroll
                for (int m = 0; m < 4; ++m)
#pragma unroll
                    for (int bj = 0; bj < 2; ++bj) { const f32x4 v0 = acc[ai][bj][m][0], v1 = acc[ai][bj][m][1];
                        float s_ = (v0[0] * v0[0] + v0[1] * v0[1]) + (v0[2] * v0[2] + v0[3] * v0[3]) + (v1[0] * v1[0] + v1[1] * v1[1]) + (v1[2] * v1[2] + v1[3] * v1[3]);
                        s_ += __shfl_xor(s_, 16); s_ += __shfl_xor(s_, 32);
                        if (fq == 0) xl[(ai * HALF + wr * 64 + m * 16 + fr) * 8 + bj * 4 + wc] = s_; }
            asm volatile("s_waitcnt lgkmcnt(0)" ::: "memory"); __builtin_amdgcn_s_barrier(); asm volatile("" ::: "memory");
            g0 = *(const f32x4*)(ng + wc * 32 + 8 * fq); g1 = *(const f32x4*)(ng + wc * 32 + 8 * fq + 4);
        }
#pragma unroll
        for (int ai = 0; ai < 2; ++ai)
#pragma unroll
            for (int m = 0; m < 4; ++m) { const int row = row0 + ai * HALF + m * 16;
                float rrow = 1.f;
                if (ACT == 2) { const f32x4 p = *(const f32x4*)(hss + (size_t)row * 4); rrow = __builtin_amdgcn_rsqf(((p[0] + p[1]) + (p[2] + p[3])) * (1.f / DM) + EPS); }
                bf16_t* rowp = hm ? base + ((size_t)((row >> 11) * NH + (colt >> 7)) * SEQ + (row & (SEQ - 1))) * HD + (wc * 32 + 8 * fq)
                                  : base + (size_t)row * ldc + col0;
                const int bstep = hm ? SEQ * HD : HALF;
#pragma unroll
                for (int bj = 0; bj < 2; ++bj) { f32x4 v0 = acc[ai][bj][m][0], v1 = acc[ai][bj][m][1];
                    if (ACT == 2) {
#pragma unroll
                        for (int i = 0; i < 4; ++i) { float a = fmaxf(v0[i] * rrow, 0.f), b = fmaxf(v1[i] * rrow, 0.f); v0[i] = a * a; v1[i] = b * b; } }
                    if (ACT == 0 && nrm) { const f32x4 p = *(const LAS f32x4*)(xl + (ai * HALF + wr * 64 + m * 16 + fr) * 8 + bj * 4);
                        const float r_ = __builtin_amdgcn_rsqf(((p[0] + p[1]) + (p[2] + p[3])) * (1.f / HD) + EPS); v0 = v0 * r_ * g0; v1 = v1 * r_ * g1; }
                    u32x4 w; w.x = cvtpk(v0[0], v0[1]); w.y = cvtpk(v0[2], v0[3]); w.z = cvtpk(v1[0], v1[1]); w.w = cvtpk(v1[2], v1[3]);
                    *(u32x4*)(rowp + bj * bstep) = w; } }
    }
};
struct EpiGate {
    static constexpr bool PERM = true, AFTER_DRAIN = false;
    const bf16_t* G0; const bf16_t* G1; bf16_t* Mg; int pm1, pn1;
    __device__ __forceinline__ void operator()(const f32x4 (&acc)[2][2][4][2], const Unit& u, int wr, int wc, int fr, int fq) const {
        const bool accum = u.pm >= pm1; const bf16_t* G = accum ? G1 : G0;
        const int pm = accum ? u.pm - pm1 : u.pm, pn = accum ? u.pn - pn1 : u.pn;
        const int row0 = pm * BM + wr * 64 + fr; const int col0 = pn * BM + wc * 32 + 8 * fq;
#pragma unroll
        for (int ai = 0; ai < 2; ++ai)
#pragma unroll
            for (int m = 0; m < 4; ++m) { const size_t ro = (size_t)(row0 + ai * HALF + m * 16) * DM + col0;
#pragma unroll
                for (int bj = 0; bj < 2; ++bj) { const f32x4 v0 = acc[ai][bj][m][0], v1 = acc[ai][bj][m][1];
                    const u32x4 g = *(const u32x4*)(G + ro + bj * HALF);
                    float r[8];
                    r[0] = sigmoidf_(bflo(g.x)) * v0[0]; r[1] = sigmoidf_(bfhi(g.x)) * v0[1]; r[2] = sigmoidf_(bflo(g.y)) * v0[2]; r[3] = sigmoidf_(bfhi(g.y)) * v0[3];
                    r[4] = sigmoidf_(bflo(g.z)) * v1[0]; r[5] = sigmoidf_(bfhi(g.z)) * v1[1]; r[6] = sigmoidf_(bflo(g.w)) * v1[2]; r[7] = sigmoidf_(bfhi(g.w)) * v1[3];
                    if (accum) { u32x4 o;
                        { const unsigned long long* mp = (const unsigned long long*)(Mg + ro + bj * HALF);
                          const unsigned long long lo = __hip_atomic_load(mp, __ATOMIC_RELAXED, __HIP_MEMORY_SCOPE_AGENT), hi2 = __hip_atomic_load(mp + 1, __ATOMIC_RELAXED, __HIP_MEMORY_SCOPE_AGENT);
                          o.x = (unsigned)lo; o.y = (unsigned)(lo >> 32); o.z = (unsigned)hi2; o.w = (unsigned)(hi2 >> 32); }
                        r[0] += bflo(o.x); r[1] += bfhi(o.x); r[2] += bflo(o.y); r[3] += bfhi(o.y); r[4] += bflo(o.z); r[5] += bfhi(o.z); r[6] += bflo(o.w); r[7] += bfhi(o.w); }
                    u32x4 w; w.x = cvtpk(r[0], r[1]); w.y = cvtpk(r[2], r[3]); w.z = cvtpk(r[4], r[5]); w.w = cvtpk(r[6], r[7]);
                    *(u32x4*)(Mg + ro + bj * HALF) = w; }
                asm volatile("" ::: "memory"); }
    }
};
template <bool STATS> struct EpiResF32 {
    static constexpr bool PERM = false, AFTER_DRAIN = false;
    const float* base; float* out; bf16_t* hb; float* hss; LAS float* xl;
    __device__ __forceinline__ void operator()(const f32x4 (&acc)[2][2][4][2], const Unit& u, int wr, int wc, int fr, int fq) const {
        const int row0 = u.pm * BM + wr * 64 + fr; const int col0 = u.pn * BM + wc * 32 + 4 * fq;
#pragma unroll
        for (int ai = 0; ai < 2; ++ai)
#pragma unroll
            for (int m = 0; m < 4; ++m) { const size_t ro = (size_t)(row0 + ai * HALF + m * 16) * DM + col0; float s_ = 0.f;
#pragma unroll
                for (int bj = 0; bj < 2; ++bj)
#pragma unroll
                    for (int n = 0; n < 2; ++n) { const size_t o = ro + bj * HALF + n * 16; const f32x4 b = *(const f32x4*)(base + o); const f32x4 h = b + acc[ai][bj][m][n]; *(f32x4*)(out + o) = h;
                        if (STATS) { u32x2 w; w.x = cvtpk(h[0], h[1]); w.y = cvtpk(h[2], h[3]); *(u32x2*)(hb + o) = w; s_ += (h[0] * h[0] + h[1] * h[1]) + (h[2] * h[2] + h[3] * h[3]); }
                        asm volatile("" ::: "memory"); }
                if (STATS) { s_ += __shfl_xor(s_, 16); s_ += __shfl_xor(s_, 32); if (fq == 0) xl[(ai * HALF + wr * 64 + m * 16 + fr) * 4 + wc] = s_; }
                asm volatile("" ::: "memory"); }
        if (STATS) {
            asm volatile("s_waitcnt lgkmcnt(0)" ::: "memory"); __builtin_amdgcn_s_barrier(); asm volatile("" ::: "memory");
            const int t_ = (int)(wr * 4 + wc) * 64 + (fq * 16 + fr);
            if (t_ < 256) { const f32x4 p = *(const LAS f32x4*)(xl + t_ * 4); hss[(size_t)(u.pm * BM + t_) * 4 + u.pn] = (p[0] + p[1]) + (p[2] + p[3]); }
        }
    }
};

template <class Epi, class Sched, bool ALIGN_EPI = false>
__device__ __forceinline__ void gemm_phase(LAS unsigned char* lds, const Gemm g, const Sched& S, const Epi& E) {
    const int tid = otid(), wid = __builtin_amdgcn_readfirstlane(tid >> 6), lane = tid & 63, wr = wid >> 2, wc = wid & 3, fr = lane & 15, fq = lane >> 4;
    const int K = g.K, nt = K / BK;
    unsigned voffA[2], voffB[2];
#pragma unroll
    for (int i = 0; i < 2; ++i) { int R, C; stage_rc(tid * 16 + i * 8192, R, C); const int Rb = Epi::PERM ? ((R & ~31) + perm32(R & 31)) : R;
        voffA[i] = (unsigned)(R * K + C) * 2u; voffB[i] = (unsigned)(Rb * K + C) * 2u; }
    const size_t kstep = (size_t)(BK * 2);
    const size_t hstep = (size_t)HALF * K * 2;
    const size_t tstep = 2 * hstep;
    const unsigned ldsw = (unsigned)wid * 1024u;
    const int aoff = lds_byte(wr * 64 + fr, fq * 8), boff = lds_byte(wc * 32 + fr, fq * 8);
#define PG8_SA(b, h) (((b) * 2 + (h)) * HTB)
#define PG8_SB(b, h) ((4 + (b) * 2 + (h)) * HTB)
#define PG8_STAGE(bufoff, gbase, voff) do { _Pragma("unroll") for (int _i = 0; _i < 2; ++_i) \
        __builtin_amdgcn_global_load_lds((const unsigned*)((const char*)(gbase) + (voff)[_i]), (LAS unsigned*)(lds + (bufoff) + ldsw + _i * 8192), 16, 0, 0); } while (0)
#define PG8_LDA(dst, b, h) do { _Pragma("unroll") for (int m = 0; m < 4; ++m) _Pragma("unroll") for (int k = 0; k < 2; ++k) dst[m][k] = *(const LAS bf16x8*)(lds + PG8_SA(b, h) + aoff + m * 2048 + k * 1024); } while (0)
#define PG8_LDB(dst, b, h) do { _Pragma("unroll") for (int n = 0; n < 2; ++n) _Pragma("unroll") for (int k = 0; k < 2; ++k) dst[n][k] = *(const LAS bf16x8*)(lds + PG8_SB(b, h) + boff + n * 2048 + k * 1024); } while (0)
#define PG8_MMA(ai, bj, At, Bt) do { __builtin_amdgcn_s_setprio(1); _Pragma("unroll") for (int m = 0; m < 4; ++m) _Pragma("unroll") for (int n = 0; n < 2; ++n) _Pragma("unroll") for (int k = 0; k < 2; ++k) \
        acc[ai][bj][m][n] = __builtin_amdgcn_mfma_f32_16x16x32_bf16(Bt[n][k], At[m][k], acc[ai][bj][m][n], 0, 0, 0); __builtin_amdgcn_s_setprio(0); } while (0)
#define PG8_WAIT_V(n) asm volatile("s_waitcnt vmcnt(" #n ")" ::: "memory")
#define PG8_WAIT_L(n) asm volatile("s_waitcnt lgkmcnt(" #n ")" ::: "memory")
#define PG8_BAR __builtin_amdgcn_s_barrier()
#define PG8_SCHED __builtin_amdgcn_sched_barrier(0)
    Unit cur, nxt; int ui = 0;
    if (!S.next(0, cur)) return;
    f32x4 acc[2][2][4][2];
#pragma unroll
    for (int a = 0; a < 2; ++a)
#pragma unroll
        for (int b = 0; b < 2; ++b)
#pragma unroll
            for (int m = 0; m < 4; ++m)
#pragma unroll
                for (int n = 0; n < 2; ++n) acc[a][b][m][n] = (f32x4){0.f, 0.f, 0.f, 0.f};
    bf16x8 At[4][2], B0[2][2], B1[2][2];
#define PG8_ABASE(pm_) ((const char*)g.A + ((pm_) >= g.pm1 ? (ptrdiff_t)((const char*)g.A1 - (const char*)g.A) + (ptrdiff_t)((size_t)((pm_) - g.pm1) * tstep) : (ptrdiff_t)((size_t)(pm_) * tstep)))
    const char* cA = PG8_ABASE(cur.pm); const char* cB = (const char*)g.Bt + (size_t)cur.pn * tstep;
    PG8_STAGE(PG8_SB(0, 0), cB, voffB); PG8_STAGE(PG8_SB(0, 1), cB + hstep, voffB); PG8_STAGE(PG8_SA(0, 0), cA, voffA); PG8_STAGE(PG8_SA(0, 1), cA + hstep, voffA);
    if (wr == 1) PG8_BAR;
    PG8_WAIT_V(2); PG8_BAR;
    PG8_STAGE(PG8_SB(1, 0), cB + kstep, voffB); PG8_STAGE(PG8_SA(1, 0), cA + kstep, voffA); PG8_STAGE(PG8_SB(1, 1), cB + hstep + kstep, voffB);
    PG8_WAIT_V(6); PG8_BAR;
    for (;;) {
        const bool has_next = S.next(ui + 1, nxt);
        const char* nA = has_next ? PG8_ABASE(nxt.pm) : cA; const char* nB = has_next ? (const char*)g.Bt + (size_t)nxt.pn * tstep : cB;
        for (int t = 0; t < nt; t += 2) {
            const bool last = (t == nt - 2);
            const char* a1 = cA + (size_t)(t + 1) * kstep;
            const char* a2 = last ? nA : cA + (size_t)(t + 2) * kstep; const char* b2 = last ? nB : cB + (size_t)(t + 2) * kstep;
            const char* a3 = a2 + kstep; const char* b3 = b2 + kstep;
            PG8_LDB(B0, 0, 0); PG8_LDB(B1, 0, 1); PG8_SCHED; PG8_LDA(At, 0, 0); PG8_STAGE(PG8_SA(1, 1), a1 + hstep, voffA);
            PG8_WAIT_V(8); PG8_WAIT_L(0); PG8_BAR; PG8_MMA(0, 0, At, B0); PG8_MMA(0, 1, At, B1); PG8_BAR; PG8_SCHED;
            PG8_LDA(At, 0, 1); PG8_STAGE(PG8_SB(0, 0), b2, voffB); PG8_STAGE(PG8_SB(0, 1), b2 + hstep, voffB); PG8_STAGE(PG8_SA(0, 0), a2, voffA);
            PG8_WAIT_V(8); PG8_WAIT_L(0); PG8_BAR; PG8_MMA(1, 0, At, B0); PG8_MMA(1, 1, At, B1); PG8_BAR; PG8_SCHED;
            PG8_LDB(B0, 1, 0); PG8_LDB(B1, 1, 1); PG8_SCHED; PG8_LDA(At, 1, 0); PG8_STAGE(PG8_SA(0, 1), a2 + hstep, voffA);
            PG8_WAIT_V(8); PG8_WAIT_L(0); PG8_BAR; PG8_MMA(0, 0, At, B0); PG8_MMA(0, 1, At, B1); PG8_BAR; PG8_SCHED;
            PG8_LDA(At, 1, 1); PG8_STAGE(PG8_SB(1, 0), b3, voffB); PG8_STAGE(PG8_SB(1, 1), b3 + hstep, voffB); PG8_STAGE(PG8_SA(1, 0), a3, voffA);
            PG8_WAIT_V(8); PG8_WAIT_L(0); PG8_BAR; PG8_MMA(1, 0, At, B0); PG8_MMA(1, 1, At, B1); PG8_BAR; PG8_SCHED;
        }
        if constexpr (ALIGN_EPI) { if (wr == 0) PG8_BAR; }
        E(acc, cur, wr, wc, fr, fq);
        if (!has_next) break;
#pragma unroll
        for (int a = 0; a < 2; ++a)
#pragma unroll
            for (int b = 0; b < 2; ++b)
#pragma unroll
                for (int m = 0; m < 4; ++m)
#pragma unroll
                    for (int n = 0; n < 2; ++n) acc[a][b][m][n] = (f32x4){0.f, 0.f, 0.f, 0.f};
        cur = nxt; cA = nA; cB = nB; ++ui;
        if constexpr (ALIGN_EPI) { if (wr == 1) PG8_BAR; }
    }
    PG8_WAIT_V(0);
    if constexpr (!ALIGN_EPI) { if (wr == 0) PG8_BAR; }
    PG8_BAR;
#undef PG8_ABASE
#undef PG8_SA
#undef PG8_SB
#undef PG8_STAGE
#undef PG8_LDA
#undef PG8_LDB
#undef PG8_MMA
#undef PG8_WAIT_V
#undef PG8_WAIT_L
#undef PG8_BAR
#undef PG8_SCHED
}
}

struct Args {
    const float* x; const float* norm_mix_g; const float* w_in; const float* conv_w; const float* a_log; const float* dt_bias;
    const float* gdn_norm_g; const float* fq_g; const float* fk_g; const float* f_bias; const float* w_pa; const float* w_pb;
    const float* w_out; const float* norm_mlp_g; const float* w_up; const float* w_dn;
    float* out; unsigned char* ws;
    int cg_seam; int pad;
};

template <int UNR = 32>
__device__ __forceinline__ void p0_transpose_item(const float* W, int K, int N, bf16_t* WT, int src_off, int dst_off, int ncols, LAS float* scr, int item, int lane, const float* kscale = nullptr  ) {
    const int nblk = ncols / 32, kb = item / nblk, nb = item % nblk, k0 = 64 * kb, n0 = 32 * nb;
#pragma unroll UNR
    for (int i = 0; i < 32; ++i) { const int kk = 2 * i + (lane >> 5); float w_ = W[(size_t)(k0 + kk) * N + src_off + n0 + (lane & 31)]; if (kscale) w_ *= kscale[k0 + kk]; scr[kk * 33 + (lane & 31)] = w_; }
    LDS_WAIT(); asm volatile("" ::: "memory");
    const int c = lane & 7;
#pragma unroll
    for (int j = 0; j < 4; ++j) { const int n = (lane >> 3) + 8 * j; const LAS float* s = scr + (8 * c) * 33 + n;
        u32x4 o; o.x = cvtpk(s[0 * 33], s[1 * 33]); o.y = cvtpk(s[2 * 33], s[3 * 33]); o.z = cvtpk(s[4 * 33], s[5 * 33]); o.w = cvtpk(s[6 * 33], s[7 * 33]);
        *(u32x4*)(WT + (size_t)(dst_off + n0 + n) * K + k0 + 8 * c) = o; }
    LDS_WAIT(); asm volatile("" ::: "memory");
}
__device__ __forceinline__ void rms_load(const float* xrow, int lane, f32x4 (&v)[4]) {
    const f32x4* xr = (const f32x4*)xrow + lane;
#pragma unroll
    for (int j = 0; j < 4; ++j) v[j] = xr[64 * j];
}
__device__ __forceinline__ void rms_finish(const float* g, bf16_t* orow, int lane, f32x4 (&v)[4]) {
    float s = 0.f;
#pragma unroll
    for (int j = 0; j < 4; ++j) s += (v[j].x * v[j].x + v[j].y * v[j].y) + (v[j].z * v[j].z + v[j].w * v[j].w);
    const float rstd = __builtin_amdgcn_rsqf(wave_sum(s) * (1.f / DM) + EPS);
    u32x2* o8 = (u32x2*)orow + lane;
#pragma unroll
    for (int j = 0; j < 4; ++j) { const f32x4 gg = ((const f32x4*)g)[lane + 64 * j]; v[j] = v[j] * rstd * gg; u32x2 w; w.x = cvtpk(v[j].x, v[j].y); w.y = cvtpk(v[j].z, v[j].w); o8[64 * j] = w; }
}

namespace fa {
constexpr int D = 128, LD = HD  , LDO = DM  , NW = 8, QBLK = 32, KVBLK = 64, QB = NW * QBLK;
constexpr int SHM_V = KVBLK * D * 2, SHM_K = KVBLK * D * 2;
constexpr int LDS_WS = 2 * SHM_V + 2 * SHM_K;
constexpr int LDS_CB = LDS_WS + NW * 64 * 4;
constexpr int LDS_TOTAL = LDS_CB + 2 * 2048 * 4;
constexpr float SCALE = SM_SCALE;
constexpr float THR = 20.f;
#define KSWZ(row, colB) ((row) * 256 + ((colB) ^ (((row) & 7) << 4)))
#define SBAR() __builtin_amdgcn_sched_barrier(0)
__device__ __forceinline__ int v_st(int k, int c) { const int kk = (k & ~0xC) | ((k & 4) << 1) | ((k & 8) >> 1); return ((kk >> 3) * 4 + (c >> 5)) * 512 + ((kk & 7) * 32 + (c & 31)) * 2; }
__device__ __forceinline__ int v_rd_base(int lane) { return ((lane & 3) << 3) | (((lane >> 2) & 3) << 6) | (((lane >> 4) & 1) << 5) | (((lane >> 5) & 1) << 8); }
constexpr int v_rd_off(int d0, int ks, int half) { return d0 * 512 + ks * 4096 + half * 2048; }
__device__ __forceinline__ int crow(int r, int hi) { return (r & 3) + 8 * (r >> 2) + 4 * hi; }
__device__ __forceinline__ bf16x8 load8(const bf16_t* p) { return *reinterpret_cast<const bf16x8*>(p); }
__device__ __forceinline__ void mask_tile(f32x16& p0, f32x16& p1, int dq) {
    const float NEG = -__builtin_inff();
#pragma unroll
    for (int r = 0; r < 16; ++r) { const int c = (r & 3) + 8 * (r >> 2); if (dq - c < 0) p0[r] = NEG; if (dq - c - 32 < 0) p1[r] = NEG; }
}
__device__ __forceinline__ void bias_tile(f32x16& p0, f32x16& p1, const float* cb) {
    { const f32x4 a0 = *(const f32x4*)(cb), a1 = *(const f32x4*)(cb + 8), a2 = *(const f32x4*)(cb + 16), a3 = *(const f32x4*)(cb + 24);
#pragma unroll
      for (int i = 0; i < 4; ++i) { p0[i] += a0[i]; p0[4 + i] += a1[i]; p0[8 + i] += a2[i]; p0[12 + i] += a3[i]; } }
    asm volatile("" ::: "memory");
    { const f32x4 a0 = *(const f32x4*)(cb + 32), a1 = *(const f32x4*)(cb + 40), a2 = *(const f32x4*)(cb + 48), a3 = *(const f32x4*)(cb + 56);
#pragma unroll
      for (int i = 0; i < 4; ++i) { p1[i] += a0[i]; p1[4 + i] += a1[i]; p1[8 + i] += a2[i]; p1[12 + i] += a3[i]; } }
    asm volatile("" ::: "memory");
}
__device__ __forceinline__ void partialSM(f32x16& p0, f32x16& p1, float& m_reg, float& mn, float& alpha) {
    float pmax = p0[0]; for (int r = 1; r < 16; ++r) pmax = fmaxf(pmax, p0[r]); for (int r = 0; r < 16; ++r) pmax = fmaxf(pmax, p1[r]);
    { auto rr = __builtin_amdgcn_permlane32_swap(__float_as_uint(pmax), __float_as_uint(pmax), false, false);
      pmax = fmaxf(__uint_as_float(rr[0]), __uint_as_float(rr[1])); }
    constexpr float C2 = 1.4426950408889634f * SCALE;
    if (__builtin_expect(__all((pmax - m_reg) * SCALE <= THR), 1)) { mn = m_reg; alpha = 1.f; }
    else { mn = fmaxf(m_reg, pmax); alpha = __builtin_amdgcn_exp2f((m_reg - mn) * C2); m_reg = mn; }
    const float mnL = -mn * C2;
    for (int r = 0; r < 16; ++r) p0[r] = fmaf(p0[r], C2, mnL); for (int r = 0; r < 16; ++r) p1[r] = fmaf(p1[r], C2, mnL);
    for (int r = 0; r < 16; ++r) p0[r] = __builtin_amdgcn_exp2f(p0[r]);
}
__device__ __forceinline__ void finishSM(f32x16& p0, f32x16& p1, float alpha, float& l_reg, bf16x8& pa0, bf16x8& pa1, bf16x8& pa2, bf16x8& pa3) {
    for (int r = 0; r < 16; ++r) p1[r] = __builtin_amdgcn_exp2f(p1[r]);
    float ps = 0; for (int r = 0; r < 16; ++r) ps += p0[r]; for (int r = 0; r < 16; ++r) ps += p1[r];
    { auto rr = __builtin_amdgcn_permlane32_swap(__float_as_uint(ps), __float_as_uint(ps), false, false);
      ps = __uint_as_float(rr[0]) + __uint_as_float(rr[1]); }
    l_reg = l_reg * alpha + ps;
#define PK4(P, B_, OUT) do { unsigned a0 = cvtpk(P[B_+0], P[B_+1]), a1 = cvtpk(P[B_+2], P[B_+3]);                          \
        unsigned b0 = cvtpk(P[B_+4], P[B_+5]), b1 = cvtpk(P[B_+6], P[B_+7]);                                             \
        auto r0 = __builtin_amdgcn_permlane32_swap(a0, b0, false, false); auto r1 = __builtin_amdgcn_permlane32_swap(a1, b1, false, false); \
        u32x4 w = {r0[0], r1[0], r0[1], r1[1]}; OUT = *reinterpret_cast<bf16x8*>(&w); } while (0)
    PK4(p0, 0, pa0); PK4(p0, 8, pa1); PK4(p1, 0, pa2); PK4(p1, 8, pa3);
#undef PK4
}
template <int KB>
__device__ __forceinline__ void qkt(f32x16& p0, f32x16& p1, const char* K_lds, int r32, int hi, const bf16x8* qr, const float* cb  ) {
#pragma unroll
    for (int g = 0; g < 4; ++g) { const f32x4 a = *(const f32x4*)(cb + 8 * g), b = *(const f32x4*)(cb + 32 + 8 * g);
#pragma unroll
        for (int i = 0; i < 4; ++i) { p0[4 * g + i] = a[i]; p1[4 * g + i] = b[i]; } }
    const char* kb[4];
#pragma unroll
    for (int dd = 0; dd < 4; ++dd) kb[dd] = K_lds + KB * SHM_K + KSWZ(r32, (dd * 16 + hi * 8) * 2);
    __builtin_amdgcn_s_setprio(1);
#pragma unroll
    for (int d0 = 0; d0 < 8; ++d0) { const char* a = kb[d0 & 3] + (d0 >> 2) * 128;
        bf16x8 b0 = *reinterpret_cast<const bf16x8*>(a);
        bf16x8 b1 = *reinterpret_cast<const bf16x8*>(a + 32 * 256);
        p0 = __builtin_amdgcn_mfma_f32_32x32x16_bf16(b0, qr[d0], p0, 0, 0, 0);
        p1 = __builtin_amdgcn_mfma_f32_32x32x16_bf16(b1, qr[d0], p1, 0, 0, 0); }
    __builtin_amdgcn_s_setprio(0);
}
template <int VB>
__device__ __forceinline__ void pv_tile(f32x16* o, int vb0, bf16x8 pa0, bf16x8 pa1, bf16x8 pa2, bf16x8 pa3) {
#define TRRD(dst, off) asm volatile("ds_read_b64_tr_b16 %0, %1 offset:%2" : "=&v"(dst) : "v"(vb0), "i"(off) : "memory")
#define PV_D0(d0) do { s16x4 l0, l1, l2, l3, h0, h1, h2, h3; constexpr int b_ = VB * SHM_V + v_rd_off(d0, 0, 0); \
        TRRD(l0, b_); TRRD(h0, b_ + 2048); TRRD(l1, b_ + 4096); TRRD(h1, b_ + 6144); TRRD(l2, b_ + 8192); TRRD(h2, b_ + 10240); TRRD(l3, b_ + 12288); TRRD(h3, b_ + 14336); \
        asm volatile("s_waitcnt lgkmcnt(0)" ::: "memory"); SBAR();   \
        o[d0] = __builtin_amdgcn_mfma_f32_32x32x16_bf16(pa0, (bf16x8){l0[0], l0[1], l0[2], l0[3], h0[0], h0[1], h0[2], h0[3]}, o[d0], 0, 0, 0);   \
        o[d0] = __builtin_amdgcn_mfma_f32_32x32x16_bf16(pa1, (bf16x8){l1[0], l1[1], l1[2], l1[3], h1[0], h1[1], h1[2], h1[3]}, o[d0], 0, 0, 0);   \
        o[d0] = __builtin_amdgcn_mfma_f32_32x32x16_bf16(pa2, (bf16x8){l2[0], l2[1], l2[2], l2[3], h2[0], h2[1], h2[2], h2[3]}, o[d0], 0, 0, 0);   \
        o[d0] = __builtin_amdgcn_mfma_f32_32x32x16_bf16(pa3, (bf16x8){l3[0], l3[1], l3[2], l3[3], h3[0], h3[1], h3[2], h3[3]}, o[d0], 0, 0, 0); } while (0)
    __builtin_amdgcn_s_setprio(1); PV_D0(0); PV_D0(1); PV_D0(2); PV_D0(3); __builtin_amdgcn_s_setprio(0);
#undef PV_D0
#undef TRRD
}
struct BlockRef { const bf16_t* Q; const bf16_t* K; const bf16_t* V; bf16_t* O; int P0; };
struct NextCtx { unsigned* ctr; int* s_item; const bf16_t* Qb; const bf16_t* Kb; const bf16_t* Vb; bf16_t* Ob; const float* cb; int nit; int xcd; };
__device__ __forceinline__ int decode_item(int li, int xcd) {
    if (li < 8) return li * 8 + xcd;
    if (li < 72) { const int k = li - 8, qb = 7 - (k >> 3), bh = (k & 7) * 8 + xcd; return 64 + (7 - qb) * 64 + bh; }
    return 2048 + (li - 72) * 8 + xcd;
}
__device__ __forceinline__ BlockRef item_ref(const NextCtx& nc, int it) {
    const int k = it - 64, qb = 7 - (k >> 6), bh = k & 63; const size_t rb = (size_t)(bh >> 3) * SEQ; const int h = bh & 7;
    BlockRef r; const size_t hb = (size_t)bh * SEQ * HD;
    r.Q = nc.Qb + hb + (size_t)qb * 256 * HD; r.K = nc.Kb + hb; r.V = nc.Vb + hb; r.O = nc.Ob + (rb + qb * 256) * DM + h * HD; r.P0 = qb * 256; return r;
}
__device__ __forceinline__ const float* item_cb(const NextCtx& nc, int it) { return nc.cb + (size_t)((it - 64) & 63) * SEQ; }
struct Seam { bf16x8 qr[8]; bf16x8 st_v0, st_v1, st_k0, st_k1; };
#define ROW(p, k0, rr) ((p) + (size_t)((k0) + (rr)) * LD + sc)
#define VMW() asm volatile("s_waitcnt vmcnt(0)" ::: "memory")
#define VMWN(n) asm volatile("s_waitcnt vmcnt(%0)" :: "i"(n) : "memory")
#define SLOAD_H(Kp, Vp, k0) do { S.st_v0 = load8(ROW(Vp, k0, sr)); S.st_v1 = load8(ROW(Vp, k0, 32 + sr));              \
                         S.st_k0 = load8(ROW(Kp, k0, sr)); S.st_k1 = load8(ROW(Kp, k0, 32 + sr)); } while (0)
#define SWRITE_HK(bf) do { *(bf16x8*)(K_lds + (bf) * SHM_K + kws) = S.st_k0; *(bf16x8*)(K_lds + (bf) * SHM_K + kws + 32 * 256) = S.st_k1; } while (0)
#define SWRITE_HV(bf) do { *(bf16x8*)(V_lds + (bf) * SHM_V + vst0) = S.st_v0; *(bf16x8*)(V_lds + (bf) * SHM_V + vst1) = S.st_v1; } while (0)
#define SWRITE_H(bf) do { SWRITE_HV(bf); SWRITE_HK(bf); } while (0)
__device__ __forceinline__ void attn_prime(const BlockRef& cur, char* lds, Seam& S) {
    const int tid = otid(), wid = __builtin_amdgcn_readfirstlane(tid >> 6), lane = tid & 63, r32 = lane & 31, hi = lane >> 5;
    const int sr = tid >> 4, sc = (tid & 15) * 8, kws = KSWZ(sr, sc * 2); char* K_lds = lds + 2 * SHM_V;
    for (int d0 = 0; d0 < 8; ++d0) S.qr[d0] = load8(cur.Q + (size_t)(wid * QBLK + r32) * LD + d0 * 16 + hi * 8);
    SLOAD_H(cur.K, cur.V, 0); VMW(); SWRITE_HK(0);
    __syncthreads();
}
__device__ __forceinline__ void attn_block(const BlockRef& cur, char* lds, Seam& S, int cbsel, const NextCtx& nc, int& itn  ) {
    const int tid = otid(), wid = __builtin_amdgcn_readfirstlane(tid >> 6), lane = tid & 63, r32 = lane & 31, hi = lane >> 5;
    const int NT = (cur.P0 + QB) / KVBLK;
    const int qlo = cur.P0 + wid * QBLK, qm = qlo + r32 - 4 * hi;
    char* V_lds = lds; char* K_lds = lds + 2 * SHM_V;
    float* ws = (float*)(lds + LDS_WS) + wid * 64; float* li_l = ws, * al_l = ws + 32;
    const float* cbl = (const float*)(lds + LDS_CB + cbsel * 8192) + 4 * hi;
    float m_reg = -1e30f, l_reg = 0; f32x16 o[4] = {};
    const int sr = tid >> 4, sc = (tid & 15) * 8, vst0 = v_st(sr, sc), vst1 = v_st(32 + sr, sc), kws = KSWZ(sr, sc * 2);
    const int vb0 = (int)(uintptr_t)V_lds + v_rd_base(lane);
    const bf16_t* Kh = cur.K; const bf16_t* Vh = cur.V;
#define RESC(a) do { if (__any((a) < 1.f)) { if (hi == 0) al_l[r32] = (a); asm volatile("s_waitcnt lgkmcnt(0)" ::: "memory");              \
                     for (int d_ = 0; d_ < 4; ++d_) for (int r = 0; r < 16; ++r) o[d_][r] *= al_l[crow(r, hi)]; } } while (0)
#define KBASE(t) ((t) * KVBLK)
#define MASKT(P0_, P1_, t) do { const int kb_ = KBASE(t); if (kb_ + KVBLK - 1 > qlo) mask_tile(P0_, P1_, qm - kb_); } while (0)
    constexpr int NQL = 8;
#define SEAM_K0() do { VMWN(NQL); SWRITE_HK(0); SBAR(); } while (0)
    f32x16 pA0, pA1, pB0, pB1; float mnA, mnB, alA, alB; bf16x8 pa0, pa1, pa2, pa3;
    SWRITE_HV(0); SBAR();
    if (NT > 1) { SLOAD_H(Kh, Vh, KBASE(1)); }
    SBAR(); qkt<0>(pA0, pA1, K_lds, r32, hi, S.qr, cbl);
    MASKT(pA0, pA1, 0); partialSM(pA0, pA1, m_reg, mnA, alA);
    if (NT > 1) { VMW(); SWRITE_H(1); }
    __syncthreads();
#define HALF_STEP(PX0, PX1, mnX, alX, PY0, PY1, alY, t, KB, VB, SB) do {                                                      \
        SBAR(); qkt<KB>(PX0, PX1, K_lds, r32, hi, S.qr, cbl + KBASE(t));                                             \
        finishSM(PY0, PY1, alY, l_reg, pa0, pa1, pa2, pa3); SBAR();                                                           \
        if ((t) + 1 < NT) { SLOAD_H(Kh, Vh, KBASE((t) + 1)); SBAR(); }                                               \
        pv_tile<VB>(o, vb0, pa0, pa1, pa2, pa3); MASKT(PX0, PX1, (t)); partialSM(PX0, PX1, m_reg, mnX, alX);                                        \
        __syncthreads();                                                                                                      \
        if ((t) + 1 < NT) { VMW(); SWRITE_H(SB); }                                                                          \
        RESC(alX); __syncthreads(); } while (0)
    for (int t = 1; t + 1 < NT; t += 2) {
        HALF_STEP(pB0, pB1, mnB, alB, pA0, pA1, alA, t, 1, 0, 0);
        HALF_STEP(pA0, pA1, mnA, alA, pB0, pB1, alB, t + 1, 0, 1, 1);
    }
    if (tid == 0) *nc.s_item = (int)atomicAdd(nc.ctr, 1u);
    __syncthreads(); itn = __builtin_amdgcn_readfirstlane(decode_item(*nc.s_item, nc.xcd)); __syncthreads();
    const bool more = itn >= 64 && itn < nc.nit;
    const BlockRef nxt = more ? item_ref(nc, itn) : cur; const float* nxt_cb = item_cb(nc, more ? itn : 64);
    if (more && wid * 256 < nxt.P0 + QB)
        __builtin_amdgcn_global_load_lds((const unsigned*)(nxt_cb + tid * 4), (LAS unsigned*)(LAS char*)(lds + LDS_CB + (cbsel ^ 1) * 8192 + wid * 1024), 16, 0, 0);
    const bool even = (NT & 1) == 0;
    if (even) { SBAR(); qkt<1>(pB0, pB1, K_lds, r32, hi, S.qr, cbl + KBASE(NT - 1)); SBAR(); }
    SLOAD_H(nxt.K, nxt.V, 0); SBAR();
#pragma unroll
    for (int d0 = 0; d0 < 8; ++d0) S.qr[d0] = load8(nxt.Q + (size_t)(wid * QBLK + r32) * LD + d0 * 16 + hi * 8);
    SBAR();
    finishSM(pA0, pA1, alA, l_reg, pa0, pa1, pa2, pa3); SBAR();
    pv_tile<0>(o, vb0, pa0, pa1, pa2, pa3);
    if (even) { MASKT(pB0, pB1, NT - 1); partialSM(pB0, pB1, m_reg, mnB, alB); __syncthreads(); RESC(alB);
        finishSM(pB0, pB1, alB, l_reg, pa0, pa1, pa2, pa3); SBAR(); pv_tile<1>(o, vb0, pa0, pa1, pa2, pa3); }
    SBAR(); SEAM_K0();
    if (hi == 0) li_l[r32] = l_reg; asm volatile("s_waitcnt lgkmcnt(0)" ::: "memory");
    float rli[16];
#pragma unroll
    for (int r = 0; r < 16; ++r) rli[r] = __builtin_amdgcn_rcpf(li_l[crow(r, hi)]);
    bf16_t* Ow = cur.O + (size_t)(wid * QBLK) * LDO;
#pragma unroll
    for (int r = 0; r < 16; ++r) { const int orow = crow(r, hi);
#pragma unroll
        for (int d0 = 0; d0 < 4; ++d0) { const float v = o[d0][r] * rli[r];
            const float vn = __shfl_xor(v, 1);
            if ((r32 & 1) == 0) *(unsigned*)(Ow + (size_t)orow * LDO + d0 * 32 + r32) = cvtpk(v, vn); } }
    __syncthreads();
#undef RESC
#undef KBASE
#undef MASKT
#undef SEAM_K0
#undef HALF_STEP
}
#undef ROW
#undef VMW
#undef VMWN
#undef SLOAD_H
#undef SWRITE_HK
#undef SWRITE_HV
#undef SWRITE_H
}

namespace gdn {
constexpr int RS = 136;
constexpr int TS = 72;
constexpr int AS = 68;
constexpr int L_RAW = 0;
constexpr int L_KBT = 0, L_VBT = 18432;
constexpr int L_QR = 54784, L_KR = 72192;
constexpr int L_A = 89600;
constexpr int L_TB = 107008;
constexpr int L_G = 116224, L_BETA = 116480;
constexpr int L_SSQ = 116736;
constexpr int L_WC = 126976;
constexpr int L_AB = 120832, L_TT = 123392, XS = 40;
__device__ __forceinline__ int crow(int r, int hi) { return (r & 3) + 8 * (r >> 2) + 4 * hi; }

__device__ __forceinline__ void raw_load(u32x4 (&rv)[7], int uidx, int tid, const bf16_t* gq, const bf16_t* gk, const bf16_t* gv) {
    const int h = uidx & 7, n = (uidx >> 3) & 31, bl = uidx >> 8; const int t0 = n * 64; const size_t rowb = (size_t)bl * SEQ;
#pragma unroll
    for (int k = 0; k < 7; ++k) { const int idx = tid + 512 * k;
        const int ten = idx / (67 * 16), rem = idx - ten * (67 * 16), row = rem >> 4, seg = rem & 15; const int t = t0 - 3 + row;
        const bf16_t* src = ten == 0 ? gq : (ten == 1 ? gk : gv);
        rv[k] = (u32x4){0u, 0u, 0u, 0u};
        if (idx < 3 * 67 * 16 && t >= 0) rv[k] = *(const u32x4*)(src + (rowb + t) * DM + h * HD + seg * 8); }
}
__device__ __forceinline__ void intra_unit(unsigned char* lds, int uidx, int unext, u32x4 (&rv)[7], int& hprev, int half, const bf16_t* gq, const bf16_t* gk, const bf16_t* gv, const float* small,
                           const float* conv_w, const float* a_log, const float* dt_bias, unsigned char* io, float* decg) {
    const int tid = otid(), lane = tid & 63, wid = __builtin_amdgcn_readfirstlane(tid >> 6), r32 = lane & 31, hi = lane >> 5;
    const int h = uidx & 7, n = (uidx >> 3) & 31, bl = uidx >> 8;
    const int t0 = n * 64; const size_t rowb = (size_t)bl * SEQ;
    const int ch = (bl * NH + h) * NCH + n;
    unsigned char* iob = io + (size_t)ch * IO_STRIDE;
    bf16_t* RAW = (bf16_t*)(lds + L_RAW);
    float* GS = (float*)(lds + L_G); float* BS = (float*)(lds + L_BETA); float* SSQ = (float*)(lds + L_SSQ);
    {
#pragma unroll
        for (int k = 0; k < 7; ++k) { const int idx = tid + 512 * k;
            const int ten = idx / (67 * 16), rem = idx - ten * (67 * 16), row = rem >> 4, seg = rem & 15;
            if (idx < 3 * 67 * 16) *(u32x4*)(RAW + (ten * 67 + row) * RS + seg * 8) = rv[k]; }
    }
    if (h != hprev) {
        float* WC = (float*)(lds + L_WC);
#pragma unroll
        for (int k = 0; k < 3; ++k) { const int j = tid + 512 * k, ten = j >> 9, tap = (j >> 7) & 3, d = j & 127; WC[j] = conv_w[(size_t)tap * 3072 + ten * 1024 + h * HD + d]; }
        hprev = h; }
    if (tid < 64) {
        const size_t grow = (size_t)half * MH + rowb + t0 + tid;
        const float ga = small[grow * 24 + h], gb = small[grow * 24 + 8 + h];
        const float xs = ga + dt_bias[h]; const float sp = xs > 20.f ? xs : log1pf(__expf(xs));
        float g = -__expf(a_log[h]) * sp;
#pragma unroll
        for (int o = 1; o < 64; o <<= 1) { const float up = __shfl_up(g, o); if (lane >= o) g += up; }
        GS[tid] = g; BS[tid] = sigmoidf_(gb);
    }
    LBAR();
    float yq[2][8], yk[2][8], yv[2][8]; float sq = 0.f, sk = 0.f;
#pragma unroll
    for (int bi = 0; bi < 2; ++bi) { const int d0 = (wid + 8 * bi) * 8;
#pragma unroll
        for (int ten = 0; ten < 3; ++ten) { float a[8];
#pragma unroll
            for (int i = 0; i < 8; ++i) a[i] = 0.f;
#pragma unroll
            for (int tap = 0; tap < 4; ++tap) { const u32x4 xr = *(const u32x4*)(RAW + (ten * 67 + lane + tap) * RS + d0);
                const float* wp = (const float*)(lds + L_WC) + (ten * 4 + tap) * 128 + d0; const f32x4 w0 = *(const f32x4*)wp, w1 = *(const f32x4*)(wp + 4);
                a[0] += w0[0] * bflo(xr.x); a[1] += w0[1] * bfhi(xr.x); a[2] += w0[2] * bflo(xr.y); a[3] += w0[3] * bfhi(xr.y);
                a[4] += w1[0] * bflo(xr.z); a[5] += w1[1] * bfhi(xr.z); a[6] += w1[2] * bflo(xr.w); a[7] += w1[3] * bfhi(xr.w); }
#pragma unroll
            for (int i = 0; i < 8; ++i) { const float y = siluf_(a[i]); if (ten == 0) { yq[bi][i] = y; sq += y * y; } else if (ten == 1) { yk[bi][i] = y; sk += y * y; } else yv[bi][i] = y; } } }
    SSQ[wid * 64 + lane] = sq; SSQ[512 + wid * 64 + lane] = sk;
    LBAR();
    {
        float tq = 0.f, tk = 0.f;
#pragma unroll
        for (int w = 0; w < 8; ++w) { tq += SSQ[w * 64 + lane]; tk += SSQ[512 + w * 64 + lane]; }
        const float rq = SM_SCALE * __builtin_amdgcn_rsqf(tq + EPS), rk = __builtin_amdgcn_rsqf(tk + EPS);
        const float G = GS[lane], beta = BS[lane], Gl = GS[63];
        const float eG = __expf(G), ekd = __expf(Gl - G), bE = beta * eG;
        bf16_t* QR = (bf16_t*)(lds + L_QR); bf16_t* KR = (bf16_t*)(lds + L_KR); bf16_t* KBT = (bf16_t*)(lds + L_KBT); bf16_t* VBT = (bf16_t*)(lds + L_VBT);
        bf16_t* gQd = (bf16_t*)(iob + IO_QD); bf16_t* gKdT = (bf16_t*)(iob + IO_KDT);
#pragma unroll
        for (int bi = 0; bi < 2; ++bi) { const int d0 = (wid + 8 * bi) * 8; float qn[8], kn[8];
#pragma unroll
            for (int i = 0; i < 8; ++i) { qn[i] = yq[bi][i] * rq; kn[i] = yk[bi][i] * rk; }
            u32x4 w;
            w.x = cvtpk(qn[0], qn[1]); w.y = cvtpk(qn[2], qn[3]); w.z = cvtpk(qn[4], qn[5]); w.w = cvtpk(qn[6], qn[7]); *(u32x4*)(QR + lane * RS + d0) = w;
            w.x = cvtpk(kn[0], kn[1]); w.y = cvtpk(kn[2], kn[3]); w.z = cvtpk(kn[4], kn[5]); w.w = cvtpk(kn[6], kn[7]); *(u32x4*)(KR + lane * RS + d0) = w;
            w.x = cvtpk(qn[0] * eG, qn[1] * eG); w.y = cvtpk(qn[2] * eG, qn[3] * eG); w.z = cvtpk(qn[4] * eG, qn[5] * eG); w.w = cvtpk(qn[6] * eG, qn[7] * eG);
            *(u32x4*)(gQd + lane * HD + d0) = w;
#pragma unroll
            for (int i = 0; i < 8; ++i) { KBT[(d0 + i) * TS + lane] = f2bf(kn[i] * bE); VBT[(d0 + i) * TS + lane] = f2bf(yv[bi][i] * beta); gKdT[(d0 + i) * 64 + lane] = f2bf(kn[i] * ekd); } }
        if (tid == 0) decg[ch] = __expf(Gl);
    }
    LBAR();
    {
        const int type = wid >> 2, it = (wid >> 1) & 1, jt = wid & 1;
        bf16_t* gAt = (bf16_t*)(iob + IO_AT); float* Af = (float*)(lds + L_A);
        const int j = 32 * jt + r32; const float Gj = GS[j];
        if (it == 0 && jt == 1) {
            if (type == 1) {
#pragma unroll
                for (int r = 0; r < 16; ++r) gAt[(crow(r, hi)) * 64 + j] = 0;
            }
        } else {
            const bf16_t* Ab = (const bf16_t*)(lds + (type ? L_QR : L_KR)) + (32 * it + r32) * RS + 8 * hi;
            const bf16_t* Bb = (const bf16_t*)(lds + L_KR) + (32 * jt + r32) * RS + 8 * hi;
            f32x16 acc = {};
#pragma unroll
            for (int s = 0; s < 8; ++s) acc = __builtin_amdgcn_mfma_f32_32x32x16_bf16(*(const bf16x8*)(Ab + 16 * s), *(const bf16x8*)(Bb + 16 * s), acc, 0, 0, 0);
            f32x4 Gr[4], Br[4];
#pragma unroll
            for (int g = 0; g < 4; ++g) { Gr[g] = *(const f32x4*)(GS + 32 * it + 8 * g + 4 * hi); Br[g] = *(const f32x4*)(BS + 32 * it + 8 * g + 4 * hi); }
            if (type == 0) {
#pragma unroll
                for (int r = 0; r < 16; ++r) { const int i = 32 * it + crow(r, hi); const float e_ = __expf(fminf(Gr[r >> 2][r & 3] - Gj, 0.f));
                    const float v_ = (i > j) ? Br[r >> 2][r & 3] * acc[r] * e_ : 0.f;
                    if (it == 1 && jt == 0) ((bf16_t*)(lds + L_AB))[(i - 32) * XS + j] = f2bf(v_); else Af[i * AS + j] = v_; }
            } else {
#pragma unroll
                for (int r = 0; r < 16; ++r) { const int i = 32 * it + crow(r, hi); const float e_ = __expf(fminf(Gr[r >> 2][r & 3] - Gj, 0.f));
                    gAt[i * 64 + j] = f2bf((i >= j) ? acc[r] * e_ : 0.f); }
            }
        }
    }
    LBAR();
    if (wid == 0) {
        const int c = lane & 31, hb = lane >> 5;
        LAS const float* Af = (LAS const float*)(lds + L_A) + (hb * 32) * AS + hb * 32;
        LAS bf16_t* TB = (LAS bf16_t*)(lds + L_TB) + (hb * 32) * TS + hb * 32 + c;
        asm volatile("" : "+v"(Af)); asm volatile("" : "+v"(TB));
        float t[32];
        f32x4 rowbuf[2][8];
        t[0] = (c == 0) ? 1.f : 0.f; TB[0] = f2bf(t[0]);
        rowbuf[1][0] = *(LAS const f32x4*)(Af + 1 * AS);
#pragma unroll
        for (int i = 1; i < 32; ++i) {
            if (i + 1 < 32) {
#pragma unroll
                for (int j4 = 0; j4 < (i + 4) / 4; ++j4) rowbuf[(i + 1) & 1][j4] = *(LAS const f32x4*)(Af + (i + 1) * AS + 4 * j4);
            }
            float s0 = (i == c) ? 1.f : 0.f, s1 = 0.f;
            asm volatile("" : "+v"(s0), "+v"(s1) :: "memory");
#pragma unroll
            for (int j4 = 0; j4 < (i + 3) / 4; ++j4) { const f32x4 a = rowbuf[i & 1][j4];
#pragma unroll
                for (int q = 0; q < 4; ++q) if (4 * j4 + q < i) { if (j4 & 1) s1 -= a[q] * t[4 * j4 + q]; else s0 -= a[q] * t[4 * j4 + q]; } }
            const float sv = s0 + s1;
            t[i] = sv; TB[i * TS] = f2bf(sv);
        }
        bf16_t* TT = (bf16_t*)(lds + L_TT); const bf16_t* AB = (const bf16_t*)(lds + L_AB);
        if (hb == 0) {
#pragma unroll
            for (int q = 0; q < 4; ++q) { u32x4 w; w.x = cvtpk(t[8 * q], t[8 * q + 1]); w.y = cvtpk(t[8 * q + 2], t[8 * q + 3]); w.z = cvtpk(t[8 * q + 4], t[8 * q + 5]); w.w = cvtpk(t[8 * q + 6], t[8 * q + 7]);
                *(u32x4*)(TT + c * XS + 8 * q) = w; }
        }
        asm volatile("s_waitcnt lgkmcnt(0)" ::: "memory");
        f32x16 Mx = {};
#pragma unroll
        for (int s2 = 0; s2 < 2; ++s2) Mx = __builtin_amdgcn_mfma_f32_32x32x16_bf16(*(const bf16x8*)(AB + c * XS + 16 * s2 + 8 * hb), *(const bf16x8*)(TT + c * XS + 16 * s2 + 8 * hb), Mx, 0, 0, 0);
        f32x16 Rx = {};
        const bf16_t* T22 = (const bf16_t*)(lds + L_TB) + (32 + c) * TS + 32 + 4 * hb;
#pragma unroll
        for (int s2 = 0; s2 < 2; ++s2) {
            u32x4 w = {cvtpk(Mx[8 * s2], Mx[8 * s2 + 1]), cvtpk(Mx[8 * s2 + 2], Mx[8 * s2 + 3]), cvtpk(Mx[8 * s2 + 4], Mx[8 * s2 + 5]), cvtpk(Mx[8 * s2 + 6], Mx[8 * s2 + 7])};
            const u32x2 a0 = *(const u32x2*)(T22 + 16 * s2), a1 = *(const u32x2*)(T22 + 16 * s2 + 8); u32x4 av = {a0.x, a0.y, a1.x, a1.y};
            Rx = __builtin_amdgcn_mfma_f32_32x32x16_bf16(__builtin_bit_cast(bf16x8, av), __builtin_bit_cast(bf16x8, w), Rx, 0, 0, 0); }
        bf16_t* T21 = (bf16_t*)(lds + L_TB) + 32 * TS + c;
#pragma unroll
        for (int r = 0; r < 16; ++r) T21[crow(r, hb) * TS] = f2bf(-Rx[r]);
        raw_load(rv, unext, tid, gq, gk, gv);
    } else {
        raw_load(rv, unext, tid, gq, gk, gv);
    }
    LBAR();
    {
        const bf16_t* TB = (const bf16_t*)(lds + L_TB);
        bf16_t* gUT = (bf16_t*)(iob + IO_UT); bf16_t* gWn = (bf16_t*)(iob + IO_WN);
#pragma unroll
        for (int qi = 0; qi < 2; ++qi) { const int q = wid * 2 + qi, type = q >> 3, it = (q >> 2) & 1, et = q & 3;
            const bf16_t* Ab = TB + (32 * it + r32) * TS + 8 * hi;
            const bf16_t* Bb = (const bf16_t*)(lds + (type ? L_KBT : L_VBT)) + (32 * et + r32) * TS + 8 * hi;
            f32x16 acc = {};
            const int ns = it ? 4 : 2;
            for (int s = 0; s < ns; ++s) acc = __builtin_amdgcn_mfma_f32_32x32x16_bf16(*(const bf16x8*)(Ab + 16 * s), *(const bf16x8*)(Bb + 16 * s), acc, 0, 0, 0);
            const int e = 32 * et + r32;
            if (type == 0) {
#pragma unroll
                for (int g = 0; g < 4; ++g) { u32x2 w; w.x = cvtpk(acc[4 * g], acc[4 * g + 1]); w.y = cvtpk(acc[4 * g + 2], acc[4 * g + 3]);
                    *(u32x2*)(gUT + e * 64 + 32 * it + 8 * g + 4 * hi) = w; }
            } else {
#pragma unroll
                for (int r = 0; r < 16; ++r) gWn[(32 * it + crow(r, hi)) * HD + e] = f2bf(-acc[r]);
            } }
    }
    LBAR();
}

constexpr int SB_WN = 0, SB_QD = 17408, SB_KDT = 34816, SB_AT = 53248, SB_SIZE = 62464;
__device__ __forceinline__ bf16x8 packb(f32x4 a, f32x4 b) { u32x4 w = {cvtpk(a[0], a[1]), cvtpk(a[2], a[3]), cvtpk(b[0], b[1]), cvtpk(b[2], b[3])}; return __builtin_bit_cast(bf16x8, w); }
__device__ __forceinline__ bf16x8 afrag(const bf16_t* p) { return *(const bf16x8*)p; }
__device__ void scan_unit(unsigned char* lds, int bh, const unsigned char* io, const float* decg, bf16_t* oa  , const bf16_t* gz, const float* gng) {
    const int tid = otid(), lane = tid & 63, wid = __builtin_amdgcn_readfirstlane(tid >> 6), fr = lane & 15, fq = lane >> 4;
    const int bl = bh >> 3, h = bh & 7;
    const unsigned char* iob = io + (size_t)bh * NCH * IO_STRIDE;
    u32x4 stA[7], stB[7];
#define SC_LOAD(st, nn) do { const unsigned char* b_ = iob + (size_t)(nn) * IO_STRIDE; \
        st[0] = *(const u32x4*)(b_ + IO_WN + tid * 16); st[1] = *(const u32x4*)(b_ + IO_WN + 8192 + tid * 16); \
        st[2] = *(const u32x4*)(b_ + IO_QD + tid * 16); st[3] = *(const u32x4*)(b_ + IO_QD + 8192 + tid * 16); \
        st[4] = *(const u32x4*)(b_ + IO_KDT + tid * 16); st[5] = *(const u32x4*)(b_ + IO_KDT + 8192 + tid * 16); \
        st[6] = *(const u32x4*)(b_ + IO_AT + tid * 16); } while (0)
#define SC_PERM(j) (32 * ((j) >> 2) + 16 * ((j) & 1) + 4 * (((j) >> 1) & 1))
#define SC_W16(base, rowstride, row, j, v) do { unsigned char* d_ = (base) + ((row) * (rowstride) + SC_PERM(j)) * 2; *(u32x2*)d_ = (u32x2){(v).x, (v).y}; *(u32x2*)(d_ + 16) = (u32x2){(v).z, (v).w}; } while (0)
#define SC_WRITE(st, bufi) do { unsigned char* l_ = lds + (bufi) * SB_SIZE; \
        { const int p = tid; SC_W16(l_ + SB_WN, RS, p >> 4, p & 15, st[0]); SC_W16(l_ + SB_QD, RS, p >> 4, p & 15, st[2]); \
          SC_W16(l_ + SB_KDT, TS, p >> 3, p & 7, st[4]); SC_W16(l_ + SB_AT, TS, p >> 3, p & 7, st[6]); } \
        { const int p = tid + 512; SC_W16(l_ + SB_WN, RS, p >> 4, p & 15, st[1]); SC_W16(l_ + SB_QD, RS, p >> 4, p & 15, st[3]); \
          SC_W16(l_ + SB_KDT, TS, p >> 3, p & 7, st[5]); } } while (0)
    f32x4 S[8];
#pragma unroll
    for (int i = 0; i < 8; ++i) S[i] = (f32x4){0.f, 0.f, 0.f, 0.f};
    SC_LOAD(stA, 0); SC_WRITE(stA, 0); SC_LOAD(stB, 1); SC_LOAD(stA, 2);
    const int e = 16 * wid + fr;
    constexpr int SB_OT = 2 * SB_SIZE, OT_SIZE = 64 * RS * 2;
    const int nrow = tid >> 3, ncs = (tid & 7) * 16;
    float* gnl = (float*)(lds + SB_OT + 2 * OT_SIZE);
    if (tid < 128) gnl[tid] = gng[tid];
    const int zoff = (bl * SEQ + nrow) * DM + h * HD + ncs;
    u32x4 zc0 = {0u, 0u, 0u, 0u}, zc1 = zc0, zn0 = zc0, zn1 = zc0;
#define SC_NORM(nn, Z0, Z1) do { const bf16_t* ot_ = (const bf16_t*)(lds + SB_OT + ((nn) & 1) * OT_SIZE) + nrow * RS + ncs; \
        const u32x4 x0 = *(const u32x4*)ot_, x1 = *(const u32x4*)(ot_ + 8); \
        float f[16] = {bflo(x0.x), bfhi(x0.x), bflo(x0.y), bfhi(x0.y), bflo(x0.z), bfhi(x0.z), bflo(x0.w), bfhi(x0.w), \
                       bflo(x1.x), bfhi(x1.x), bflo(x1.y), bfhi(x1.y), bflo(x1.z), bfhi(x1.z), bflo(x1.w), bfhi(x1.w)}; \
        float z[16] = {bflo(Z0.x), bfhi(Z0.x), bflo(Z0.y), bfhi(Z0.y), bflo(Z0.z), bfhi(Z0.z), bflo(Z0.w), bfhi(Z0.w), \
                       bflo(Z1.x), bfhi(Z1.x), bflo(Z1.y), bfhi(Z1.y), bflo(Z1.z), bfhi(Z1.z), bflo(Z1.w), bfhi(Z1.w)}; \
        float ss = 0.f; _Pragma("unroll") for (int i = 0; i < 16; ++i) ss += f[i] * f[i]; \
        ss += __shfl_xor(ss, 1); ss += __shfl_xor(ss, 2); ss += __shfl_xor(ss, 4); \
        const float rstd = __builtin_amdgcn_rsqf(ss * (1.f / HD) + EPS); \
        _Pragma("unroll") for (int q = 0; q < 4; ++q) { const f32x4 g4 = *(const f32x4*)(gnl + ncs + 4 * q); \
            _Pragma("unroll") for (int i = 0; i < 4; ++i) f[4 * q + i] = f[4 * q + i] * rstd * g4[i] * siluf_(z[4 * q + i]); } \
        u32x4 y0, y1; y0.x = cvtpk(f[0], f[1]); y0.y = cvtpk(f[2], f[3]); y0.z = cvtpk(f[4], f[5]); y0.w = cvtpk(f[6], f[7]); \
        y1.x = cvtpk(f[8], f[9]); y1.y = cvtpk(f[10], f[11]); y1.z = cvtpk(f[12], f[13]); y1.w = cvtpk(f[14], f[15]); \
        bf16_t* op_ = oa + (zoff + (nn) * 64 * DM); *(u32x4*)op_ = y0; *(u32x4*)(op_ + 8) = y1; } while (0)
    u32x2 un[4]; float decn;
    { const bf16_t* ut = (const bf16_t*)(iob + IO_UT) + e * 64 + 4 * fq;
#pragma unroll
      for (int tt = 0; tt < 4; ++tt) un[tt] = *(const u32x2*)(ut + 16 * tt);
      decn = decg[bh * NCH]; }
    LBAR();
    for (int n2 = 0; n2 < NCH; n2 += 2) {
#pragma unroll
    for (int par = 0; par < 2; ++par) { const int n = n2 + par;
        const unsigned char* L = lds + (n & 1) * SB_SIZE;
        f32x4 vn[4], o[4]; const float dec = decn;
#pragma unroll
        for (int tt = 0; tt < 4; ++tt) { vn[tt] = (f32x4){bflo(un[tt].x), bfhi(un[tt].x), bflo(un[tt].y), bfhi(un[tt].y)}; o[tt] = (f32x4){0.f, 0.f, 0.f, 0.f}; }
        if (n + 1 < NCH) {
            const bf16_t* ut = (const bf16_t*)(iob + (size_t)(n + 1) * IO_STRIDE + IO_UT) + e * 64 + 4 * fq;
#pragma unroll
            for (int tt = 0; tt < 4; ++tt) un[tt] = *(const u32x2*)(ut + 16 * tt);
            decn = decg[bh * NCH + n + 1]; }
        zn0 = *(const u32x4*)(gz + (zoff + n * 64 * DM)); zn1 = *(const u32x4*)(gz + (zoff + n * 64 * DM + 8));
        if (n > 0) SC_NORM(n - 1, zc0, zc1);
        zc0 = zn0; zc1 = zn1;
        bf16x8 Sb[4];
#pragma unroll
        for (int k = 0; k < 4; ++k) Sb[k] = packb(S[2 * k], S[2 * k + 1]);
        const bf16_t* Wn = (const bf16_t*)(L + SB_WN) + fr * RS + 8 * fq; const bf16_t* Qd = (const bf16_t*)(L + SB_QD) + fr * RS + 8 * fq;
        const bf16_t* At = (const bf16_t*)(L + SB_AT) + fr * TS + 8 * fq; const bf16_t* Kd = (const bf16_t*)(L + SB_KDT) + fr * TS + 8 * fq;
        bf16x8 fa[2][4];
#define SC_LD4(buf, p0, p1, p2, p3) do { fa[buf][0] = afrag(p0); fa[buf][1] = afrag(p1); fa[buf][2] = afrag(p2); fa[buf][3] = afrag(p3); } while (0)
#define SC_LDG4(g, buf) do { \
        if ((g) < 8) { const int tt_ = (g) >> 1, k0_ = 2 * ((g) & 1); SC_LD4(buf, Wn + 16 * tt_ * RS + 32 * k0_, Qd + 16 * tt_ * RS + 32 * k0_, Wn + 16 * tt_ * RS + 32 * (k0_ + 1), Qd + 16 * tt_ * RS + 32 * (k0_ + 1)); } \
        else if ((g) < 10) { const int t0_ = 2 * ((g) - 8); SC_LD4(buf, At + 16 * t0_ * TS, At + 16 * (t0_ + 1) * TS, At + 16 * t0_ * TS + 32, At + 16 * (t0_ + 1) * TS + 32); } \
        else { const int d0_ = 2 * ((g) - 10); SC_LD4(buf, Kd + 16 * d0_ * TS, Kd + 16 * (d0_ + 1) * TS, Kd + 16 * d0_ * TS + 32, Kd + 16 * (d0_ + 1) * TS + 32); } } while (0)
#define SC_MMA(acc, A, B) acc = __builtin_amdgcn_mfma_f32_16x16x32_bf16(A, B, acc, 0, 0, 0)
        SC_LDG4(0, 0);
#pragma unroll
        for (int g = 0; g < 8; ++g) { const int tt = g >> 1, k0 = 2 * (g & 1);
            SC_LDG4(g + 1, (g + 1) & 1);
            asm volatile("" : "+v"(vn[tt]), "+v"(o[tt]) :: "memory");
            SC_MMA(vn[tt], fa[g & 1][0], Sb[k0]); SC_MMA(o[tt], fa[g & 1][1], Sb[k0]); SC_MMA(vn[tt], fa[g & 1][2], Sb[k0 + 1]); SC_MMA(o[tt], fa[g & 1][3], Sb[k0 + 1]); }
        bf16x8 vb[2];
        vb[0] = packb(vn[0], vn[1]); vb[1] = packb(vn[2], vn[3]);
#pragma unroll
        for (int g = 8; g < 10; ++g) { const int t0 = 2 * (g - 8);
            SC_LDG4(g + 1, (g + 1) & 1);
            asm volatile("" : "+v"(o[t0]), "+v"(o[t0 + 1]) :: "memory");
            SC_MMA(o[t0], fa[g & 1][0], vb[0]); SC_MMA(o[t0 + 1], fa[g & 1][1], vb[0]); SC_MMA(o[t0], fa[g & 1][2], vb[1]); SC_MMA(o[t0 + 1], fa[g & 1][3], vb[1]); }
#pragma unroll
        for (int dt = 0; dt < 8; ++dt) S[dt] = S[dt] * dec;
#pragma unroll
        for (int g = 10; g < 14; ++g) { const int d0 = 2 * (g - 10);
            if (g < 13) SC_LDG4(g + 1, (g + 1) & 1);
            asm volatile("" : "+v"(S[d0]), "+v"(S[d0 + 1]) :: "memory");
            SC_MMA(S[d0], fa[g & 1][0], vb[0]); SC_MMA(S[d0 + 1], fa[g & 1][1], vb[0]); SC_MMA(S[d0], fa[g & 1][2], vb[1]); SC_MMA(S[d0 + 1], fa[g & 1][3], vb[1]); }
#undef SC_LDG4
#undef SC_LD4
#undef SC_MMA
        { bf16_t* ot = (bf16_t*)(lds + SB_OT + (n & 1) * OT_SIZE) + (4 * fq) * RS + e;
#pragma unroll
          for (int tt = 0; tt < 4; ++tt)
#pragma unroll
              for (int i = 0; i < 4; ++i) ot[(16 * tt + i) * RS] = f2bf(o[tt][i]); }
        if (n + 1 < NCH) { if (par == 0) SC_WRITE(stB, 1); else SC_WRITE(stA, 0); }
        if (n + 3 < NCH) { if (par == 0) SC_LOAD(stB, n + 3); else SC_LOAD(stA, n + 3); }
        LBAR();
    } }
    SC_NORM(NCH - 1, zc0, zc1);
    LBAR();
#undef SC_NORM
#undef SC_LOAD
#undef SC_WRITE
}
}

#define XB_TMO      128
#define XB_XCNT(j)  (256  + 64 * (j))
#define XB_XSUB(j)  (1280 + 64 * (j))
#define XB_XGEN(j)  (2304 + 64 * (j))
#define XB_TOP      3328
#define XB_TOPGEN   3392
#define XCD_BAR_WORDS 3456
#define XB_SPIN_CAP (1u << 22)
__device__ __forceinline__ unsigned xb_ld(unsigned* p)              { return __hip_atomic_load(p, __ATOMIC_RELAXED, __HIP_MEMORY_SCOPE_AGENT); }
__device__ __forceinline__ unsigned xb_add(unsigned* p, unsigned v) { return __hip_atomic_fetch_add(p, v, __ATOMIC_RELAXED, __HIP_MEMORY_SCOPE_AGENT); }
__device__ __forceinline__ unsigned xb_xcc_id() { return (unsigned)__builtin_amdgcn_s_getreg((3 << 11) | 20) & 0xFu; }
#define XB_SPIN(cond, bar) do { unsigned _sp = 0; while (cond) {        \
    if ((++_sp & 255u) == 0u) { if (xb_ld(&(bar)[XB_TMO])) break; if (_sp > XB_SPIN_CAP) { atomicAdd(&(bar)[XB_TMO], 1u); break; } } } } while (0)
struct XcdBarrier { unsigned* bar; unsigned x; volatile LAS unsigned* st; };
__device__ __forceinline__ XcdBarrier xcd_barrier_post(unsigned* bar, volatile LAS unsigned* st) {
    XcdBarrier b; b.bar = bar; b.x = xb_xcc_id(); b.st = st;
    if (threadIdx.x == 0) (void)xb_add(&bar[XB_XCNT(b.x)], 1u);
    return b;
}
__device__ __forceinline__ void xcd_barrier_complete(unsigned* bar, unsigned x, unsigned& nloc, unsigned& nx) {
    const unsigned G = gridDim.x * gridDim.y * gridDim.z;
    unsigned sum, cnt, mine, sp = 0u;
    for (;;) {
        sum = 0u; cnt = 0u; mine = 0u;
#pragma unroll
        for (unsigned j = 0; j < 16; ++j) { const unsigned c = xb_ld(&bar[XB_XCNT(j)]); sum += c; cnt += (c > 0u) ? 1u : 0u; mine = (j == x) ? c : mine; }
        if (sum == G) break;
        __builtin_amdgcn_s_sleep(1);
        if ((++sp & 255u) == 0u) { if (xb_ld(&bar[XB_TMO])) break; if (sp > XB_SPIN_CAP) { atomicAdd(&bar[XB_TMO], 1u); break; } }
    }
    nloc = mine > 0u ? mine : 1u; nx = cnt > 0u ? cnt : 1u;
}
__device__ __forceinline__ void xcd_barrier(const XcdBarrier& b) {
    asm volatile("s_waitcnt vmcnt(0)" ::: "memory");
    __syncthreads();
    if (threadIdx.x == 0) {
        unsigned* bar = b.bar;
        __builtin_amdgcn_s_waitcnt(0);
        unsigned nloc = b.st[0], nx = b.st[1];
        if (nloc == 0u) { xcd_barrier_complete(bar, b.x, nloc, nx); b.st[0] = nloc; b.st[1] = nx; }
        const unsigned old = xb_add(&bar[XB_XSUB(b.x)], 1u);
        const unsigned gen = old / nloc;
        if (old + 1u == (gen + 1u) * nloc) {
            __builtin_amdgcn_fence(__ATOMIC_RELEASE, "agent");
            asm volatile("s_waitcnt vmcnt(0)" ::: "memory");
            const unsigned og = xb_add(&bar[XB_TOP], 1u);
            const unsigned tg = og / nx;
            if (og + 1u == (tg + 1u) * nx) xb_add(&bar[XB_TOPGEN], 1u);
            else XB_SPIN(xb_ld(&bar[XB_TOPGEN]) == tg, bar);
            __builtin_amdgcn_fence(__ATOMIC_ACQUIRE, "agent");
            xb_add(&bar[XB_XGEN(b.x)], 1u);
            asm volatile("s_waitcnt vmcnt(0)" ::: "memory");
        } else {
            XB_SPIN(xb_ld(&bar[XB_XGEN(b.x)]) == gen, bar);
            __builtin_amdgcn_fence(__ATOMIC_ACQUIRE, "agent");
            asm volatile("s_waitcnt vmcnt(0)" ::: "memory");
        }
    }
    __syncthreads();
}

__global__ void __launch_bounds__(512, 2) hybrid_fwd(Args a) {
    extern __shared__ __attribute__((aligned(16))) unsigned char lds_raw[];
    cg::grid_group grid = cg::this_grid();
    LAS unsigned char* ldsL = (LAS unsigned char*)lds_raw;
    const int G = gridDim.x, NGW = G * 8;
    { volatile LAS unsigned* z = (volatile LAS unsigned*)(ldsL + LDS_BYTES - 32); if (threadIdx.x < 2) z[threadIdx.x] = 0u; }
    __syncthreads();
    const XcdBarrier xbar = xcd_barrier_post((unsigned*)(a.ws + WS_CTL) + 4096, (volatile LAS unsigned*)(ldsL + LDS_BYTES - 32));
#define WSB() ({ size_t z_ = 0; asm volatile("" : "+s"(z_)); a.ws + z_; })

#if !defined(OFF_P0)
    for (int rep0 = 0; rep0 < 1 + DUP_P0; ++rep0) {
        const int tid = otid(), lane = tid & 63, wid = __builtin_amdgcn_readfirstlane(tid >> 6), gw = blockIdx.x * 8 + wid; (void)tid; (void)lane; (void)gw;
        LAS float* scr = (LAS float*)(ldsL + wid * 16384);
        constexpr int I_A = 16 * 128, I_B = 16 * 96, I_C = 16 * 64;
        constexpr int NITEMS = I_A + I_B + I_C;
        for (int it = gw; it < NITEMS; it += NGW) {
            int r = it;
            if (r < I_A) { p0_transpose_item(a.w_in, DM, NIN, ((bf16_t*)(WSB() + WS_WIN)), 0, 0, 4096, scr, r, lane); continue; } r -= I_A;
            if (r < I_B) { p0_transpose_item(a.w_in, DM, NIN, ((bf16_t*)(WSB() + WS_WIN)), 4112, 4096, 3072, scr, r, lane); continue; } r -= I_B;
            p0_transpose_item(a.w_in, DM, NIN, ((bf16_t*)(WSB() + WS_WIN)), 7192, 7168, 2048, scr, r, lane);
        }
        __syncthreads();
        float* wsm = (float*)lds_raw;
        {
            f32x4 wv[2][6]; const float gk[2] = {a.norm_mix_g[tid], a.norm_mix_g[tid + 512]};
#pragma unroll
            for (int kk = 0; kk < 2; ++kk) { const float* wr_ = a.w_in + (size_t)(tid + 512 * kk) * NIN;
#pragma unroll
                for (int q = 0; q < 4; ++q) wv[kk][q] = *(const f32x4*)(wr_ + 4096 + 4 * q);
                wv[kk][4] = *(const f32x4*)(wr_ + 7184); wv[kk][5] = *(const f32x4*)(wr_ + 7188); }
#pragma unroll
            for (int kk = 0; kk < 2; ++kk)
#pragma unroll
                for (int q = 0; q < 6; ++q)
#pragma unroll
                    for (int i = 0; i < 4; ++i) wsm[(4 * q + i) * 1024 + tid + 512 * kk] = wv[kk][q][i] * gk[kk];
        }
        __syncthreads();
        if (wid < 4) {
            typedef float f32x16v __attribute__((ext_vector_type(16)));
            const int i = lane & 31, kk = lane >> 5;
            float* rsl = (float*)(lds_raw + 98304) + wid * 32;
            for (int tile = blockIdx.x * 4 + wid; tile < MTOT / 32; tile += G * 4) {
                const float* xr = a.x + (size_t)(32 * tile + i) * DM + kk * 4;
                const float* wl = wsm + (i < 24 ? i : 0) * 1024 + kk * 4;
                f32x16v acc = {}; float ssq = 0.f;
#pragma unroll 16
                for (int c = 0; c < 128; ++c) { const f32x4 av = *(const f32x4*)(xr + c * 8); const f32x4 bv = *(const f32x4*)(wl + c * 8);
                    ssq += (av.x * av.x + av.y * av.y) + (av.z * av.z + av.w * av.w);
                    acc = __builtin_amdgcn_mfma_f32_32x32x2f32(av.x, bv.x, acc, 0, 0, 0); acc = __builtin_amdgcn_mfma_f32_32x32x2f32(av.y, bv.y, acc, 0, 0, 0);
                    acc = __builtin_amdgcn_mfma_f32_32x32x2f32(av.z, bv.z, acc, 0, 0, 0); acc = __builtin_amdgcn_mfma_f32_32x32x2f32(av.w, bv.w, acc, 0, 0, 0); }
                { auto rr = __builtin_amdgcn_permlane32_swap(__float_as_uint(ssq), __float_as_uint(ssq), false, false); ssq = __uint_as_float(rr[0]) + __uint_as_float(rr[1]); }
                if (kk == 0) rsl[i] = __builtin_amdgcn_rsqf(ssq * (1.f / DM) + EPS);
                asm volatile("s_waitcnt lgkmcnt(0)" ::: "memory");
                if (i < 24) {
#pragma unroll
                    for (int g = 0; g < 4; ++g) { const f32x4 r4 = *(const f32x4*)(rsl + 8 * g + 4 * kk);
#pragma unroll
                        for (int q = 0; q < 4; ++q) ((float*)(WSB() + WS_SMALL))[(size_t)(32 * tile + 8 * g + 4 * kk + q) * 24 + i] = acc[4 * g + q] * r4[q]; } }
                asm volatile("s_waitcnt lgkmcnt(0)" ::: "memory");
            }
        } else {
            const int gw4 = blockIdx.x * 4 + (wid - 4), NGW4 = G * 4;
            for (int m = gw4; m < MTOT; m += 2 * NGW4) {
                f32x4 va[4], vb[4];
                rms_load(a.x + (size_t)m * DM, lane, va); rms_load(a.x + (size_t)(m + NGW4) * DM, lane, vb);
                rms_finish(a.norm_mix_g, ((bf16_t*)((unsigned char*)a.out + 64 * MiB)) + (size_t)m * DM, lane, va); rms_finish(a.norm_mix_g, ((bf16_t*)((unsigned char*)a.out + 64 * MiB)) + (size_t)(m + NGW4) * DM, lane, vb);
            }
        }
        __syncthreads();
    }
#endif
    if (a.cg_seam) grid.sync(); else GSYNC();

    for (int half = 0; half < NHALF; ++half) {
        const size_t roff = (size_t)half * MH;
#if !defined(OFF_G1)
        {
            pg8::Gemm g{((bf16_t*)((unsigned char*)a.out + 64 * MiB)) + roff * DM, ((bf16_t*)(WSB() + WS_WIN)), MH, NPROJ, DM}; pg8::StaticOrder S; S.init(MH, NPROJ, G, (int)blockIdx.x);
            pg8::EpiBf16<0> E{((bf16_t*)(WSB() + WS_PROJ + (size_t)(0) * GRP)), DM, DM, GRP / 2, 4, 7, 4, 6, a.fq_g, a.fk_g, (LAS float*)(ldsL + 131072), nullptr};
            for (int rep = 0; rep < 1 + DUP_G1; ++rep)
            pg8::gemm_phase<pg8::EpiBf16<0>, pg8::StaticOrder, true>(ldsL, g, S, E);
        }
#endif
        GSYNC();
        {
#if !defined(OFF_PREPAB)
            const int tid = otid(), lane = tid & 63, wid = __builtin_amdgcn_readfirstlane(tid >> 6), gw = blockIdx.x * 8 + wid; (void)tid; (void)lane; (void)gw;
            for (int bh = gw; bh < BH * NH; bh += NGW) { const int bl = bh >> 3, h = bh & 7; const float fb = a.f_bias[h];
                const float* sp = ((float*)(WSB() + WS_SMALL)) + (roff + (size_t)bl * SEQ + lane * 32) * 24 + 16 + h; float loc[32]; float run = 0.f;
#pragma unroll
                for (int i = 0; i < 32; ++i) { const float xv = sp[(size_t)i * 24] + fb; const float ls = fminf(xv, 0.f) - log1pf(__expf(-fabsf(xv))); run += ls; loc[i] = run; }
                float inc = run;
#pragma unroll
                for (int o = 1; o < 64; o <<= 1) { const float up = __shfl_up(inc, o); if (lane >= o) inc += up; }
                const float excl = inc - run; float* cp = ((float*)(WSB() + WS_CB)) + ((size_t)(half * BH * NH + bh)) * SEQ + lane * 32;
#pragma unroll
                for (int i = 0; i < 32; ++i) cp[i] = -(excl + loc[i]) * (1.f / SM_SCALE); }
#endif
#ifndef NO_INTRA
            { u32x4 rv[7]; int hprev = -1; const int NU = BH * NH * NCH;
              gdn::raw_load(rv, blockIdx.x, tid, ((bf16_t*)(WSB() + WS_PROJ + (size_t)(0) * GRP)), ((bf16_t*)(WSB() + WS_PROJ + (size_t)(1) * GRP)), ((bf16_t*)(WSB() + WS_PROJ + (size_t)(2) * GRP)));
              for (int u = blockIdx.x; u < NU; u += G)
                  gdn::intra_unit(lds_raw, u, u + G < NU ? u + G : u  , rv, hprev, half, ((bf16_t*)(WSB() + WS_PROJ + (size_t)(0) * GRP)), ((bf16_t*)(WSB() + WS_PROJ + (size_t)(1) * GRP)), ((bf16_t*)(WSB() + WS_PROJ + (size_t)(2) * GRP)), ((float*)(WSB() + WS_SMALL)), a.conv_w, a.a_log, a.dt_bias, (WSB() + WS_IO), ((float*)(WSB() + WS_DEC))); }
#endif
        }
        GSYNC();
        {
            const int tid = otid(), lane = tid & 63, wid = __builtin_amdgcn_readfirstlane(tid >> 6), gw = blockIdx.x * 8 + wid; (void)tid; (void)lane; (void)gw;
            LAS int* s_item = (LAS int*)(ldsL + LDS_BYTES - 64);
            for (int rep = 0; rep < 1 + (DUP_SA ? 1 : 0); ++rep) {
            const int xcd = blockIdx.x & 7;
            unsigned* ctr = ((unsigned*)(WSB() + WS_CTL)) + 64 * (8 + (half * 2 + rep) * 8 + xcd);
            if (rep) xcd_barrier(xbar);
            const int NIT = (rep && DUP_SA == 2) ? 64 : 64 + 512;
            fa::Seam S = {}; bool primed = false; int cbsel = 0;
            fa::NextCtx nc; nc.ctr = ctr; nc.s_item = (int*)(lds_raw + LDS_BYTES - 64); nc.Qb = ((bf16_t*)(WSB() + WS_PROJ + (size_t)(4) * GRP)); nc.Kb = ((bf16_t*)(WSB() + WS_PROJ + (size_t)(5) * GRP)); nc.Vb = ((bf16_t*)(WSB() + WS_PROJ + (size_t)(6) * GRP)); nc.Ob = ((bf16_t*)(WSB() + WS_PROJ + 2 * GRP)); nc.cb = ((float*)(WSB() + WS_CB)) + (size_t)(half * BH * NH) * SEQ; nc.nit = NIT; nc.xcd = xcd;
#define Q_FETCH(dst) do { if (tid == 0) *s_item = (int)atomicAdd(ctr, 1u); __syncthreads(); dst = __builtin_amdgcn_readfirstlane(fa::decode_item(*s_item, xcd)); __syncthreads(); } while (0)
            const int NTR = (rep ? 0 : (half == 0 ? 192 : 512));
            int it; Q_FETCH(it);
            while (it < NIT) {
#ifndef NO_SCAN
                if (it < 64) { gdn::scan_unit(lds_raw, it, (WSB() + WS_IO), ((float*)(WSB() + WS_DEC)), ((bf16_t*)(WSB() + WS_PROJ)), ((bf16_t*)(WSB() + WS_PROJ + (size_t)(3) * GRP)), a.gdn_norm_g); primed = false; S = fa::Seam{}; Q_FETCH(it); continue; }
#endif
#ifndef NO_ATTN
                {
                    const fa::BlockRef cur = fa::item_ref(nc, it);
                    if (!primed) {
                        float* cbl = (float*)(lds_raw + fa::LDS_CB + cbsel * 8192);
                        if (tid * 4 < cur.P0 + 256) *(f32x4*)(cbl + tid * 4) = *(const f32x4*)(fa::item_cb(nc, it) + tid * 4);
                        fa::attn_prime(cur, (char*)lds_raw, S); }
                    int itn;
                    fa::attn_block(cur, (char*)lds_raw, S, cbsel, nc, itn);
                    primed = itn >= 64 && itn < NIT; if (primed) cbsel ^= 1;
                    it = itn;
                }
#else
                Q_FETCH(it);
#endif
            }
            while (it >= 2048 && it < 2048 + NTR) {
                const int witem = (it - 2048) * 8 + wid; LAS float* scr = (LAS float*)(ldsL + wid * 16384);
                if (half == 0) { const int m = witem >> 9, r = witem & 511; p0_transpose_item<8>(m == 0 ? a.w_pa : (m == 1 ? a.w_pb : a.w_out), DM, DM, m == 0 ? ((bf16_t*)(WSB() + WS_WPA)) : (m == 1 ? ((bf16_t*)(WSB() + WS_WPB)) : ((bf16_t*)(WSB() + WS_WOUT))), 0, 0, DM, scr, r, lane); }
                else { if (witem < 2048) p0_transpose_item<8>(a.w_up, DM, DFF, ((bf16_t*)(WSB() + WS_WUP)), 0, 0, DFF, scr, witem, lane, a.norm_mlp_g); else p0_transpose_item<8>(a.w_dn, DFF, DM, ((bf16_t*)(WSB() + WS_WDN)), 0, 0, DM, scr, witem - 2048, lane); }
                __syncthreads(); Q_FETCH(it); }
#undef Q_FETCH
#undef A_REF
#undef A_CB
            }
        }
#if 0
        {
            const int tid = otid(), lane = tid & 63, wid = __builtin_amdgcn_readfirstlane(tid >> 6), gw = blockIdx.x * 8 + wid; (void)tid; (void)lane; (void)gw;
            for (int m = gw; m < MH; m += 2 * NGW) {
                u32x4 xin[2][4];
#pragma unroll
                for (int q = 0; q < 2; ++q) { const bf16_t* p = ((bf16_t*)(WSB() + WS_PROJ)) + (size_t)(m + q * NGW) * DM + lane * 16; const bf16_t* zp = ((bf16_t*)(WSB() + WS_PROJ + (size_t)(3) * GRP)) + (size_t)(m + q * NGW) * DM + lane * 16;
                    xin[q][0] = *(const u32x4*)p; xin[q][1] = *(const u32x4*)(p + 8); xin[q][2] = *(const u32x4*)zp; xin[q][3] = *(const u32x4*)(zp + 8); }
#pragma unroll
                for (int q = 0; q < 2; ++q) { bf16_t* p = ((bf16_t*)(WSB() + WS_PROJ)) + (size_t)(m + q * NGW) * DM + lane * 16; const float* gg = a.gdn_norm_g + (lane & 7) * 16;
                    const u32x4 x0 = xin[q][0], x1 = xin[q][1], z0 = xin[q][2], z1 = xin[q][3];
                    float f[16] = {bflo(x0.x), bfhi(x0.x), bflo(x0.y), bfhi(x0.y), bflo(x0.z), bfhi(x0.z), bflo(x0.w), bfhi(x0.w),
                                   bflo(x1.x), bfhi(x1.x), bflo(x1.y), bfhi(x1.y), bflo(x1.z), bfhi(x1.z), bflo(x1.w), bfhi(x1.w)};
                    float z[16] = {bflo(z0.x), bfhi(z0.x), bflo(z0.y), bfhi(z0.y), bflo(z0.z), bfhi(z0.z), bflo(z0.w), bfhi(z0.w),
                                   bflo(z1.x), bfhi(z1.x), bflo(z1.y), bfhi(z1.y), bflo(z1.z), bfhi(z1.z), bflo(z1.w), bfhi(z1.w)};
                    float s = 0.f;
#pragma unroll
                    for (int i = 0; i < 16; ++i) s += f[i] * f[i];
                    s += __shfl_xor(s, 1); s += __shfl_xor(s, 2); s += __shfl_xor(s, 4);
                    const float rstd = __builtin_amdgcn_rsqf(s * (1.f / HD) + EPS);
#pragma unroll
                    for (int i = 0; i < 16; ++i) f[i] = f[i] * rstd * gg[i] * siluf_(z[i]);
                    u32x4 y0, y1; y0.x = cvtpk(f[0], f[1]); y0.y = cvtpk(f[2], f[3]); y0.z = cvtpk(f[4], f[5]); y0.w = cvtpk(f[6], f[7]);
                    y1.x = cvtpk(f[8], f[9]); y1.y = cvtpk(f[10], f[11]); y1.z = cvtpk(f[12], f[13]); y1.w = cvtpk(f[14], f[15]);
                    *(u32x4*)p = y0; *(u32x4*)(p + 8) = y1; }
            }
        }
#endif
        GSYNC();
#if !defined(OFF_G2)
        {
            static_assert(WS_WPB == WS_WPA + (size_t)DM * DM * 2, "P_B's bf16 copy must follow P_A's: the second stage's B tiles are addressed as rows 1024.. of one [2048][1024] matrix");
            pg8::Gemm g{((bf16_t*)(WSB() + WS_PROJ)), ((bf16_t*)(WSB() + WS_WPA)), MH, DM, DM, (const bf16_t*)(WSB() + WS_PROJ + 2 * GRP), MH / 256};
            pg8::TwoStageOrder S; S.base.init(MH, DM, G, (int)blockIdx.x); S.dpm = MH / 256; S.dpn = DM / 256;
            pg8::EpiGate E{((bf16_t*)(WSB() + WS_PROJ + (size_t)(7) * GRP)), ((bf16_t*)(WSB() + WS_PROJ + (size_t)(8) * GRP)), (bf16_t*)(WSB() + (half == 0 ? WS_MG0 : WS_PROJ + 3 * GRP)), MH / 256, DM / 256};
            pg8::gemm_phase<pg8::EpiGate, pg8::TwoStageOrder, true>(ldsL, g, S, E);
        }
#endif
        GSYNC();
    }
#if !defined(OFF_G4)
    {
        pg8::Gemm g{(const bf16_t*)(WSB() + WS_MG0), ((bf16_t*)(WSB() + WS_WOUT)), MTOT, DM, DM, (const bf16_t*)(WSB() + WS_PROJ + 3 * GRP), MH / 256}; pg8::StaticOrder S; S.init(MTOT, DM, G, (int)blockIdx.x);
        pg8::EpiResF32<true> E{a.x, a.out, (bf16_t*)(WSB() + WS_HB), (float*)(WSB() + WS_HSS), (LAS float*)(ldsL + 131072)};
        for (int r4 = 0; r4 < 1 + DUP_G4; ++r4)
        pg8::gemm_phase<pg8::EpiResF32<true>, pg8::StaticOrder, true>(ldsL, g, S, E);
    }
#endif
    GSYNC();
    bf16_t* ACT = (bf16_t*)(WSB() + WS_ACT);
#if !defined(OFF_G5)
    {
        pg8::Gemm g{(const bf16_t*)(WSB() + WS_HB), ((bf16_t*)(WSB() + WS_WUP)), MTOT, DFF, DM}; pg8::StaticOrder S; S.init(MTOT, DFF, G, (int)blockIdx.x);
        pg8::EpiBf16<2> E{ACT, DFF, 0, 0, 0, 0, 0, 0, nullptr, nullptr, (LAS float*)(ldsL + 131072), (const float*)(WSB() + WS_HSS)};
        for (int r5 = 0; r5 < 1 + DUP_G5; ++r5)
        pg8::gemm_phase<pg8::EpiBf16<2>, pg8::StaticOrder, true>(ldsL, g, S, E);
    }
#endif
    GSYNC();
#if !defined(OFF_G6)
    {
        pg8::Gemm g{ACT, ((bf16_t*)(WSB() + WS_WDN)), MTOT, DM, DFF}; pg8::StaticOrder S; S.init(MTOT, DM, G, (int)blockIdx.x);
        pg8::EpiResF32<false> E{a.out, a.out, nullptr, nullptr, (LAS float*)(ldsL + 131072)};
        pg8::gemm_phase<pg8::EpiResF32<false>, pg8::StaticOrder, true>(ldsL, g, S, E);
    }
#endif
}

extern "C" void kernel_launch(void* const* d_in, const int* in_sizes, int n_in, void* d_out, int out_size, void* d_ws, size_t ws_size, hipStream_t stream) {
    static int grid = 0;
    if (grid == 0) {
        if (n_in != 16 || in_sizes[0] != MTOT * DM || out_size != MTOT * DM || ws_size < WS_END) {
            fprintf(stderr, "kernel_launch: unexpected shapes / workspace (n_in %d, in0 %d, out %d, ws %zu)\n", n_in, n_in > 0 ? in_sizes[0] : -1, out_size, ws_size); grid = -1; return; }
        int dev = 0, cus = 0, per_cu = 0;
        (void)hipGetDevice(&dev); (void)hipDeviceGetAttribute(&cus, hipDeviceAttributeMultiprocessorCount, dev);
        if (hipFuncSetAttribute((const void*)hybrid_fwd, hipFuncAttributeMaxDynamicSharedMemorySize, LDS_BYTES) != hipSuccess) { fprintf(stderr, "kernel_launch: hipFuncSetAttribute failed\n"); grid = -1; return; }
        if (hipOccupancyMaxActiveBlocksPerMultiprocessor(&per_cu, (const void*)hybrid_fwd, 512, LDS_BYTES) != hipSuccess || per_cu < 1) { fprintf(stderr, "kernel_launch: occupancy query says %d\n", per_cu); per_cu = 1; }
        (void)hipGetLastError();
        grid = cus * 1;
        if (grid <= 0) grid = 256;
    }
    if (grid < 0) return;
    (void)hipMemsetAsync((char*)d_ws + WS_CTL, 0, 65536, stream);
    Args a{};
    a.x = (const float*)d_in[0]; a.norm_mix_g = (const float*)d_in[1]; a.w_in = (const float*)d_in[2]; a.conv_w = (const float*)d_in[3];
    a.a_log = (const float*)d_in[4]; a.dt_bias = (const float*)d_in[5]; a.gdn_norm_g = (const float*)d_in[6]; a.fq_g = (const float*)d_in[7];
    a.fk_g = (const float*)d_in[8]; a.f_bias = (const float*)d_in[9]; a.w_pa = (const float*)d_in[10]; a.w_pb = (const float*)d_in[11];
    a.w_out = (const float*)d_in[12]; a.norm_mlp_g = (const float*)d_in[13]; a.w_up = (const float*)d_in[14]; a.w_dn = (const float*)d_in[15];
    a.out = (float*)d_out; a.ws = (unsigned char*)d_ws; a.cg_seam = 0; a.pad = 0;
    void* args[] = {&a};
    hipError_t e = hipLaunchCooperativeKernel((const void*)hybrid_fwd, dim3(grid), dim3(512), args, LDS_BYTES, stream);
    if (e != hipSuccess) fprintf(stderr, "kernel_launch: cooperative launch failed: %s (grid %d)\n", hipGetErrorString(e), grid);
}
```

```cpp
#include <hip/hip_runtime.h>
#include <hip/hip_bf16.h>
#include <hip/hip_cooperative_groups.h>
#include <cstdio>
#include <cstdint>
namespace cg = cooperative_groups;

#define LAS __attribute__((address_space(3)))
typedef unsigned short bf16_t;
typedef short bf16x8 __attribute__((ext_vector_type(8)));
typedef short s16x4 __attribute__((ext_vector_type(4)));
typedef float f32x4 __attribute__((ext_vector_type(4)));
typedef float f32x16 __attribute__((ext_vector_type(16)));
typedef float f32x2 __attribute__((ext_vector_type(2)));
typedef unsigned u32x4 __attribute__((ext_vector_type(4)));
typedef unsigned u32x2 __attribute__((ext_vector_type(2)));
typedef __bf16 bf16x2_t __attribute__((ext_vector_type(2)));

constexpr int BATCH = 16, SEQ = 2048, DM = 1024, NH = 8, HD = 128, DFF = 4096, NIN = 9240;
constexpr int MTOT = BATCH * SEQ;
constexpr int NHALF = 2, MH = MTOT / NHALF;
constexpr int BH = BATCH / NHALF;
constexpr int NPROJ = 9216;
constexpr float EPS = 1e-6f;
constexpr float SM_SCALE = 0.08838834764831845f;
constexpr int NCH = SEQ / 64;

constexpr size_t MiB = 1u << 20;
constexpr size_t WS_CTL = 0;
constexpr size_t WS_WIN = 1 * MiB;
constexpr size_t WS_WPA = 19 * MiB, WS_WPB = 21 * MiB, WS_WOUT = 23 * MiB, WS_WUP = 25 * MiB, WS_WDN = 33 * MiB;
constexpr size_t WS_SMALL = 41 * MiB;
constexpr size_t WS_CB = 44 * MiB;
constexpr size_t WS_DEC = 45 * MiB;
constexpr size_t WS_PROJ = 48 * MiB;
constexpr size_t GRP = 32 * MiB;
constexpr size_t WS_IO = 336 * MiB;
constexpr size_t WS_HSS = 45 * MiB + 65536;
constexpr size_t WS_MG0 = 480 * MiB;
constexpr size_t WS_HB = 176 * MiB;
constexpr size_t WS_ACT = 240 * MiB;
constexpr size_t WS_END = 512 * MiB;
constexpr size_t IO_STRIDE = 73728;
constexpr size_t IO_WN = 0, IO_QD = 16384, IO_KDT = 32768, IO_AT = 49152, IO_UT = 57344;
constexpr int LDS_BYTES = 163840;
#define DUP_SYNC 0
#define DUP_SA 0
#define DUP_INTRA 0
#define DUP_G1 0
#define DUP_P0 0
#define DUP_G4 0
#define DUP_G5 0
#define GSYNC() do { xcd_barrier(xbar); if (DUP_SYNC) xcd_barrier(xbar); } while (0)

__device__ __forceinline__ unsigned cvtpk(float lo, float hi) { f32x2 v = {lo, hi}; bf16x2_t b = __builtin_convertvector(v, bf16x2_t); return __builtin_bit_cast(unsigned, b); }
__device__ __forceinline__ float bflo(unsigned w) { return __uint_as_float(w << 16); }
__device__ __forceinline__ float bfhi(unsigned w) { return __uint_as_float(w & 0xffff0000u); }
__device__ __forceinline__ bf16_t f2bf(float f) { return (bf16_t)(cvtpk(f, 0.f) & 0xffffu); }
__device__ __forceinline__ float bf2f(bf16_t h) { return __uint_as_float(((unsigned)h) << 16); }
__device__ __forceinline__ float wave_sum(float v) {
#pragma unroll
    for (int o = 1; o < 64; o <<= 1) v += __shfl_xor(v, o);
    return v;
}
__device__ __forceinline__ float sigmoidf_(float x) { return __builtin_amdgcn_rcpf(1.f + __expf(-x)); }
__device__ __forceinline__ float siluf_(float x) { return x * __builtin_amdgcn_rcpf(1.f + __expf(-x)); }
__device__ __forceinline__ int otid() { int t = threadIdx.x; asm volatile("" : "+v"(t)); return t; }
#define LDS_WAIT() asm volatile("s_waitcnt lgkmcnt(0)" ::: "memory")
#define LBAR() do { asm volatile("s_waitcnt lgkmcnt(0)" ::: "memory"); __builtin_amdgcn_s_barrier(); asm volatile("" ::: "memory"); } while (0)

namespace pg8 {
constexpr int BM = 256, BK = 64, HALF = 128, HTB = HALF * BK * 2, STAGE_BYTES = 8 * HTB, NXCD = 8, WGM = 8;
__host__ __device__ __forceinline__ int lds_byte(int r, int c) { const int st = (r >> 4) * 2 + (c >> 5), rr = r & 15, cc = c & 31, ob = rr * 64 + cc * 2; return st * 1024 + (ob ^ (((ob >> 9) & 1) << 5)); }
__host__ __device__ __forceinline__ void stage_rc(int b, int& R, int& C) { const int st = b / 1024, sb = b % 1024, swz = sb ^ (((sb >> 9) & 1) << 5); R = (st >> 1) * 16 + swz / 64; C = (st & 1) * 32 + (swz % 64) / 2; }
__host__ __device__ __forceinline__ int perm32(int rho) { const int n = rho >> 4, i = rho & 15; return 8 * (i >> 2) + 4 * n + (i & 3); }
struct Unit { int pm, pn; };
struct Gemm { const bf16_t* A; const bf16_t* Bt; int M, N, K; const bf16_t* A1 = nullptr; int pm1 = 1 << 30; };
struct StaticOrder {
    int nM, nN, nwg, G, c;
    __host__ __device__ void init(int M, int N, int G_, int c_) { nM = M / BM; nN = N / BM; nwg = nM * nN; G = G_; c = c_; }
    __host__ __device__ bool next(int i, Unit& u) const {
        const long L = (long)i * G + c; if (L >= nwg) return false;
        int wgid = (int)L; { const int q = nwg / NXCD, r = nwg % NXCD, xcd = wgid % NXCD, off = wgid / NXCD; wgid = (xcd < r ? xcd * (q + 1) : r * (q + 1) + (xcd - r) * q) + off; }
        const int nig = WGM * nN, gid = wgid / nig, fm = gid * WGM, gsz = (nM - fm) < WGM ? (nM - fm) : WGM;
        u.pm = fm + ((wgid % nig) % gsz); u.pn = (wgid % nig) / gsz; return true;
    }
    __device__ __forceinline__ void a_ready(const Unit&) const {}
    __device__ __forceinline__ void done(const Unit&) const {}
};
struct TwoStageOrder {
    StaticOrder base; int dpm, dpn;
    __device__ bool next(int i, Unit& u) const { Unit b; if (!base.next(i >> 1, b)) return false; u.pm = b.pm + (i & 1) * dpm; u.pn = b.pn + (i & 1) * dpn; return true; }
    __device__ __forceinline__ void a_ready(const Unit&) const {}
    __device__ __forceinline__ void done(const Unit&) const {}
};
template <int ACT  > struct EpiBf16 {
    static constexpr bool PERM = true, AFTER_DRAIN = false;
    bf16_t* O; int ldc; int split_cols; size_t split_stride; int hm_lo, hm_hi;
    int nrm_lo, nrm_hi; const float* ng0; const float* ng1; LAS float* xl; const float* hss;
    __device__ __forceinline__ void operator()(const f32x4 (&acc)[2][2][4][2], const Unit& u, int wr, int wc, int fr, int fq) const {
        const int row0 = u.pm * BM + wr * 64 + fr; int colt = u.pn * BM; bf16_t* base = O; bool hm = false, nrm = false; const float* ng = ng0;
        if (split_cols) { const int t = colt / split_cols; base += (size_t)t * split_stride; colt -= t * split_cols; hm = t >= hm_lo && t < hm_hi; nrm = t >= nrm_lo && t < nrm_hi; if (t > nrm_lo) ng = ng1; }
        const int col0 = colt + wc * 32 + 8 * fq;
        f32x4 g0 = {1.f, 1.f, 1.f, 1.f}, g1 = g0;
        if (ACT == 0 && nrm) {
#pragma unroll
            for (int ai = 0; ai < 2; ++ai)
#pragma unroll
                for (int m = 0; m < 4; ++m)
#pragma unroll
                    for (int bj = 0; bj < 2; ++bj) { const f32x4 v0 = acc[ai][bj][m][0], v1 = acc[ai][bj][m][1];
                        float s_ = (v0[0] * v0[0] + v0[1] * v0[1]) + (v0[2] * v0[2] + v0[3] * v0[3]) + (v1[0] * v1[0] + v1[1] * v1[1]) + (v1[2] * v1[2] + v1[3] * v1[3]);
                        s_ += __shfl_xor(s_, 16); s_ += __shfl_xor(s_, 32);
                        if (fq == 0) xl[(ai * HALF + wr * 64 + m * 16 + fr) * 8 + bj * 4 + wc] = s_; }
            asm volatile("s_waitcnt lgkmcnt(0)" ::: "memory"); __builtin_amdgcn_s_barrier(); asm volatile("" ::: "memory");
            g0 = *(const f32x4*)(ng + wc * 32 + 8 * fq); g1 = *(const f32x4*)(ng + wc * 32 + 8 * fq + 4);
        }
#pragma unroll
        for (int ai = 0; ai < 2; ++ai)
#pragma unroll
            for (int m = 0; m < 4; ++m) { const int row = row0 + ai * HALF + m * 16;
                float rrow = 1.f;
                if (ACT == 2) { const f32x4 p = *(const f32x4*)(hss + (size_t)row * 4); rrow = __builtin_amdgcn_rsqf(((p[0] + p[1]) + (p[2] + p[3])) * (1.f / DM) + EPS); }
                bf16_t* rowp = hm ? base + ((size_t)((row >> 11) * NH + (colt >> 7)) * SEQ + (row & (SEQ - 1))) * HD + (wc * 32 + 8 * fq)
                                  : base + (size_t)row * ldc + col0;
                const int bstep = hm ? SEQ * HD : HALF;
#pragma unroll
                for (int bj = 0; bj < 2; ++bj) { f32x4 v0 = acc[ai][bj][m][0], v1 = acc[ai][bj][m][1];
                    if (ACT == 2) {
#pragma unroll
                        for (int i = 0; i < 4; ++i) { float a = fmaxf(v0[i] * rrow, 0.f), b = fmaxf(v1[i] * rrow, 0.f); v0[i] = a * a; v1[i] = b * b; } }
                    if (ACT == 0 && nrm) { const f32x4 p = *(const LAS f32x4*)(xl + (ai * HALF + wr * 64 + m * 16 + fr) * 8 + bj * 4);
                        const float r_ = __builtin_amdgcn_rsqf(((p[0] + p[1]) + (p[2] + p[3])) * (1.f / HD) + EPS); v0 = v0 * r_ * g0; v1 = v1 * r_ * g1; }
                    u32x4 w; w.x = cvtpk(v0[0], v0[1]); w.y = cvtpk(v0[2], v0[3]); w.z = cvtpk(v1[0], v1[1]); w.w = cvtpk(v1[2], v1[3]);
                    *(u32x4*)(rowp + bj * bstep) = w; } }
    }
};
struct EpiGate {
    static constexpr bool PERM = true, AFTER_DRAIN = false;
    const bf16_t* G0; const bf16_t* G1; bf16_t* Mg; int pm1, pn1;
    __device__ __forceinline__ void operator()(const f32x4 (&acc)[2][2][4][2], const Unit& u, int wr, int wc, int fr, int fq) const {
        const bool accum = u.pm >= pm1; const bf16_t* G = accum ? G1 : G0;
        const int pm = accum ? u.pm - pm1 : u.pm, pn = accum ? u.pn - pn1 : u.pn;
        const int row0 = pm * BM + wr * 64 + fr; const int col0 = pn * BM + wc * 32 + 8 * fq;
#pragma unroll
        for (int ai = 0; ai < 2; ++ai)
#pragma unroll
            for (int m = 0; m < 4; ++m) { const size_t ro = (size_t)(row0 + ai * HALF + m * 16) * DM + col0;
#pragma unroll
                for (int bj = 0; bj < 2; ++bj) { const f32x4 v0 = acc[ai][bj][m][0], v1 = acc[ai][bj][m][1];
                    const u32x4 g = *(const u32x4*)(G + ro + bj * HALF);
                    float r[8];
                    r[0] = sigmoidf_(bflo(g.x)) * v0[0]; r[1] = sigmoidf_(bfhi(g.x)) * v0[1]; r[2] = sigmoidf_(bflo(g.y)) * v0[2]; r[3] = sigmoidf_(bfhi(g.y)) * v0[3];
                    r[4] = sigmoidf_(bflo(g.z)) * v1[0]; r[5] = sigmoidf_(bfhi(g.z)) * v1[1]; r[6] = sigmoidf_(bflo(g.w)) * v1[2]; r[7] = sigmoidf_(bfhi(g.w)) * v1[3];
                    if (accum) { u32x4 o;
                        { const unsigned long long* mp = (const unsigned long long*)(Mg + ro + bj * HALF);
                          const unsigned long long lo = __hip_atomic_load(mp, __ATOMIC_RELAXED, __HIP_MEMORY_SCOPE_AGENT), hi2 = __hip_atomic_load(mp + 1, __ATOMIC_RELAXED, __HIP_MEMORY_SCOPE_AGENT);
                          o.x = (unsigned)lo; o.y = (unsigned)(lo >> 32); o.z = (unsigned)hi2; o.w = (unsigned)(hi2 >> 32); }
                        r[0] += bflo(o.x); r[1] += bfhi(o.x); r[2] += bflo(o.y); r[3] += bfhi(o.y); r[4] += bflo(o.z); r[5] += bfhi(o.z); r[6] += bflo(o.w); r[7] += bfhi(o.w); }
                    u32x4 w; w.x = cvtpk(r[0], r[1]); w.y = cvtpk(r[2], r[3]); w.z = cvtpk(r[4], r[5]); w.w = cvtpk(r[6], r[7]);
                    *(u32x4*)(Mg + ro + bj * HALF) = w; }
                asm volatile("" ::: "memory"); }
    }
};
template <bool STATS> struct EpiResF32 {
    static constexpr bool PERM = false, AFTER_DRAIN = false;
    const float* base; float* out; bf16_t* hb; float* hss; LAS float* xl;
    __device__ __forceinline__ void operator()(const f32x4 (&acc)[2][2][4][2], const Unit& u, int wr, int wc, int fr, int fq) const {
        const int row0 = u.pm * BM + wr * 64 + fr; const int col0 = u.pn * BM + wc * 32 + 4 * fq;
#pragma unroll
        for (int ai = 0; ai < 2; ++ai)
#pragma unroll
            for (int m = 0; m < 4; ++m) { const size_t ro = (size_t)(row0 + ai * HALF + m * 16) * DM + col0; float s_ = 0.f;
#pragma unroll
                for (int bj = 0; bj < 2; ++bj)
#pragma unroll
                    for (int n = 0; n < 2; ++n) { const size_t o = ro + bj * HALF + n * 16; const f32x4 b = *(const f32x4*)(base + o); const f32x4 h = b + acc[ai][bj][m][n]; *(f32x4*)(out + o) = h;
                        if (STATS) { u32x2 w; w.x = cvtpk(h[0], h[1]); w.y = cvtpk(h[2], h[3]); *(u32x2*)(hb + o) = w; s_ += (h[0] * h[0] + h[1] * h[1]) + (h[2] * h[2] + h[3] * h[3]); }
                        asm volatile("" ::: "memory"); }
                if (STATS) { s_ += __shfl_xor(s_, 16); s_ += __shfl_xor(s_, 32); if (fq == 0) xl[(ai * HALF + wr * 64 + m * 16 + fr) * 4 + wc] = s_; }
                asm volatile("" ::: "memory"); }
        if (STATS) {
            asm volatile("s_waitcnt lgkmcnt(0)" ::: "memory"); __builtin_amdgcn_s_barrier(); asm volatile("" ::: "memory");
            const int t_ = (int)(wr * 4 + wc) * 64 + (fq * 16 + fr);
            if (t_ < 256) { const f32x4 p = *(const LAS f32x4*)(xl + t_ * 4); hss[(size_t)(u.pm * BM + t_) * 4 + u.pn] = (p[0] + p[1]) + (p[2] + p[3]); }
        }
    }
};

template <class Epi, class Sched, bool ALIGN_EPI = false>
__device__ __forceinline__ void gemm_phase(LAS unsigned char* lds, const Gemm g, const Sched& S, const Epi& E) {
    const int tid = otid(), wid = __builtin_amdgcn_readfirstlane(tid >> 6), lane = tid & 63, wr = wid >> 2, wc = wid & 3, fr = lane & 15, fq = lane >> 4;
    const int K = g.K, nt = K / BK;
    unsigned voffA[2], voffB[2];
#pragma unroll
    for (int i = 0; i < 2; ++i) { int R, C; stage_rc(tid * 16 + i * 8192, R, C); const int Rb = Epi::PERM ? ((R & ~31) + perm32(R & 31)) : R;
        voffA[i] = (unsigned)(R * K + C) * 2u; voffB[i] = (unsigned)(Rb * K + C) * 2u; }
    const size_t kstep = (size_t)(BK * 2);
    const size_t hstep = (size_t)HALF * K * 2;
    const size_t tstep = 2 * hstep;
    const unsigned ldsw = (unsigned)wid * 1024u;
    const int aoff = lds_byte(wr * 64 + fr, fq * 8), boff = lds_byte(wc * 32 + fr, fq * 8);
#define PG8_SA(b, h) (((b) * 2 + (h)) * HTB)
#define PG8_SB(b, h) ((4 + (b) * 2 + (h)) * HTB)
#define PG8_STAGE(bufoff, gbase, voff) do { _Pragma("unroll") for (int _i = 0; _i < 2; ++_i) \
        __builtin_amdgcn_global_load_lds((const unsigned*)((const char*)(gbase) + (voff)[_i]), (LAS unsigned*)(lds + (bufoff) + ldsw + _i * 8192), 16, 0, 0); } while (0)
#define PG8_LDA(dst, b, h) do { _Pragma("unroll") for (int m = 0; m < 4; ++m) _Pragma("unroll") for (int k = 0; k < 2; ++k) dst[m][k] = *(const LAS bf16x8*)(lds + PG8_SA(b, h) + aoff + m * 2048 + k * 1024); } while (0)
#define PG8_LDB(dst, b, h) do { _Pragma("unroll") for (int n = 0; n < 2; ++n) _Pragma("unroll") for (int k = 0; k < 2; ++k) dst[n][k] = *(const LAS bf16x8*)(lds + PG8_SB(b, h) + boff + n * 2048 + k * 1024); } while (0)
#define PG8_MMA(ai, bj, At, Bt) do { __builtin_amdgcn_s_setprio(1); _Pragma("unroll") for (int m = 0; m < 4; ++m) _Pragma("unroll") for (int n = 0; n < 2; ++n) _Pragma("unroll") for (int k = 0; k < 2; ++k) \
        acc[ai][bj][m][n] = __builtin_amdgcn_mfma_f32_16x16x32_bf16(Bt[n][k], At[m][k], acc[ai][bj][m][n], 0, 0, 0); __builtin_amdgcn_s_setprio(0); } while (0)
#define PG8_WAIT_V(n) asm volatile("s_waitcnt vmcnt(" #n ")" ::: "memory")
#define PG8_WAIT_L(n) asm volatile("s_waitcnt lgkmcnt(" #n ")" ::: "memory")
#define PG8_BAR __builtin_amdgcn_s_barrier()
#define PG8_SCHED __builtin_amdgcn_sched_barrier(0)
    Unit cur, nxt; int ui = 0;
    if (!S.next(0, cur)) return;
    f32x4 acc[2][2][4][2];
#pragma unroll
    for (int a = 0; a < 2; ++a)
#pragma unroll
        for (int b = 0; b < 2; ++b)
#pragma unroll
            for (int m = 0; m < 4; ++m)
#pragma unroll
                for (int n = 0; n < 2; ++n) acc[a][b][m][n] = (f32x4){0.f, 0.f, 0.f, 0.f};
    bf16x8 At[4][2], B0[2][2], B1[2][2];
#define PG8_ABASE(pm_) ((const char*)g.A + ((pm_) >= g.pm1 ? (ptrdiff_t)((const char*)g.A1 - (const char*)g.A) + (ptrdiff_t)((size_t)((pm_) - g.pm1) * tstep) : (ptrdiff_t)((size_t)(pm_) * tstep)))
    const char* cA = PG8_ABASE(cur.pm); const char* cB = (const char*)g.Bt + (size_t)cur.pn * tstep;
    PG8_STAGE(PG8_SB(0, 0), cB, voffB); PG8_STAGE(PG8_SB(0, 1), cB + hstep, voffB); PG8_STAGE(PG8_SA(0, 0), cA, voffA); PG8_STAGE(PG8_SA(0, 1), cA + hstep, voffA);
    if (wr == 1) PG8_BAR;
    PG8_WAIT_V(2); PG8_BAR;
    PG8_STAGE(PG8_SB(1, 0), cB + kstep, voffB); PG8_STAGE(PG8_SA(1, 0), cA + kstep, voffA); PG8_STAGE(PG8_SB(1, 1), cB + hstep + kstep, voffB);
    PG8_WAIT_V(6); PG8_BAR;
    for (;;) {
        const bool has_next = S.next(ui + 1, nxt);
        const char* nA = has_next ? PG8_ABASE(nxt.pm) : cA; const char* nB = has_next ? (const char*)g.Bt + (size_t)nxt.pn * tstep : cB;
        for (int t = 0; t < nt; t += 2) {
            const bool last = (t == nt - 2);
            const char* a1 = cA + (size_t)(t + 1) * kstep;
            const char* a2 = last ? nA : cA + (size_t)(t + 2) * kstep; const char* b2 = last ? nB : cB + (size_t)(t + 2) * kstep;
            const char* a3 = a2 + kstep; const char* b3 = b2 + kstep;
            PG8_LDB(B0, 0, 0); PG8_LDB(B1, 0, 1); PG8_SCHED; PG8_LDA(At, 0, 0); PG8_STAGE(PG8_SA(1, 1), a1 + hstep, voffA);
            PG8_WAIT_V(8); PG8_WAIT_L(0); PG8_BAR; PG8_MMA(0, 0, At, B0); PG8_MMA(0, 1, At, B1); PG8_BAR; PG8_SCHED;
            PG8_LDA(At, 0, 1); PG8_STAGE(PG8_SB(0, 0), b2, voffB); PG8_STAGE(PG8_SB(0, 1), b2 + hstep, voffB); PG8_STAGE(PG8_SA(0, 0), a2, voffA);
            PG8_WAIT_V(8); PG8_WAIT_L(0); PG8_BAR; PG8_MMA(1, 0, At, B0); PG8_MMA(1, 1, At, B1); PG8_BAR; PG8_SCHED;
            PG8_LDB(B0, 1, 0); PG8_LDB(B1, 1, 1); PG8_SCHED; PG8_LDA(At, 1, 0); PG8_STAGE(PG8_SA(0, 1), a2 + hstep, voffA);
            PG8_WAIT_V(8); PG8_WAIT_L(0); PG8_BAR; PG8_MMA(0, 0, At, B0); PG8_MMA(0, 1, At, B1); PG8_BAR; PG8_SCHED;
            PG8_LDA(At, 1, 1); PG8_STAGE(PG8_SB(1, 0), b3, voffB); PG8_STAGE(PG8_SB(1, 1), b3 + hstep, voffB); PG8_STAGE(PG8_SA(1, 0), a3, voffA);
            PG8_WAIT_V(8); PG8_WAIT_L(0); PG8_BAR; PG8_MMA(1, 0, At, B0); PG8_MMA(1, 1, At, B1); PG8_BAR; PG8_SCHED;
        }
        if constexpr (ALIGN_EPI) { if (wr == 0) PG8_BAR; }
        E(acc, cur, wr, wc, fr, fq);
        if (!has_next) break;
#pragma unroll
        for (int a = 0; a < 2; ++a)
#pragma unroll
            for (int b = 0; b < 2; ++b)
#pragma unroll
                for (int m = 0; m < 4; ++m)
#pragma unroll
                    for (int n = 0; n < 2; ++n) acc[a][b][m][n] = (f32x4){0.f, 0.f, 0.f, 0.f};
        cur = nxt; cA = nA; cB = nB; ++ui;
        if constexpr (ALIGN_EPI) { if (wr == 1) PG8_BAR; }
    }
    PG8_WAIT_V(0);
    if constexpr (!ALIGN_EPI) { if (wr == 0) PG8_BAR; }
    PG8_BAR;
#undef PG8_ABASE
#undef PG8_SA
#undef PG8_SB
#undef PG8_STAGE
#undef PG8_LDA
#undef PG8_LDB
#undef PG8_MMA
#undef PG8_WAIT_V
#undef PG8_WAIT_L
#undef PG8_BAR
#undef PG8_SCHED
}
}

struct Args {
    const float* x; const float* norm_mix_g; const float* w_in; const float* conv_w; const float* a_log; const float* dt_bias;
    const float* gdn_norm_g; const float* fq_g; const float* fk_g; const float* f_bias; const float* w_pa; const float* w_pb;
    const float* w_out; const float* norm_mlp_g; const float* w_up; const float* w_dn;
    float* out; unsigned char* ws;
    int cg_seam; int pad;
};

template <int UNR = 32>
__device__ __forceinline__ void p0_transpose_item(const float* W, int K, int N, bf16_t* WT, int src_off, int dst_off, int ncols, LAS float* scr, int item, int lane, const float* kscale = nullptr  ) {
    const int nblk = ncols / 32, kb = item / nblk, nb = item % nblk, k0 = 64 * kb, n0 = 32 * nb;
#pragma unroll UNR
    for (int i = 0; i < 32; ++i) { const int kk = 2 * i + (lane >> 5); float w_ = W[(size_t)(k0 + kk) * N + src_off + n0 + (lane & 31)]; if (kscale) w_ *= kscale[k0 + kk]; scr[kk * 33 + (lane & 31)] = w_; }
    LDS_WAIT(); asm volatile("" ::: "memory");
    const int c = lane & 7;
#pragma unroll
    for (int j = 0; j < 4; ++j) { const int n = (lane >> 3) + 8 * j; const LAS float* s = scr + (8 * c) * 33 + n;
        u32x4 o; o.x = cvtpk(s[0 * 33], s[1 * 33]); o.y = cvtpk(s[2 * 33], s[3 * 33]); o.z = cvtpk(s[4 * 33], s[5 * 33]); o.w = cvtpk(s[6 * 33], s[7 * 33]);
        *(u32x4*)(WT + (size_t)(dst_off + n0 + n) * K + k0 + 8 * c) = o; }
    LDS_WAIT(); asm volatile("" ::: "memory");
}
__device__ __forceinline__ void rms_load(const float* xrow, int lane, f32x4 (&v)[4]) {
    const f32x4* xr = (const f32x4*)xrow + lane;
#pragma unroll
    for (int j = 0; j < 4; ++j) v[j] = xr[64 * j];
}
__device__ __forceinline__ void rms_finish(const float* g, bf16_t* orow, int lane, f32x4 (&v)[4]) {
    float s = 0.f;
#pragma unroll
    for (int j = 0; j < 4; ++j) s += (v[j].x * v[j].x + v[j].y * v[j].y) + (v[j].z * v[j].z + v[j].w * v[j].w);
    const float rstd = __builtin_amdgcn_rsqf(wave_sum(s) * (1.f / DM) + EPS);
    u32x2* o8 = (u32x2*)orow + lane;
#pragma unroll
    for (int j = 0; j < 4; ++j) { const f32x4 gg = ((const f32x4*)g)[lane + 64 * j]; v[j] = v[j] * rstd * gg; u32x2 w; w.x = cvtpk(v[j].x, v[j].y); w.y = cvtpk(v[j].z, v[j].w); o8[64 * j] = w; }
}

namespace fa {
constexpr int D = 128, LD = HD  , LDO = DM  , NW = 8, QBLK = 32, KVBLK = 64, QB = NW * QBLK;
constexpr int SHM_V = KVBLK * D * 2, SHM_K = KVBLK * D * 2;
constexpr int LDS_WS = 2 * SHM_V + 2 * SHM_K;
constexpr int LDS_CB = LDS_WS + NW * 64 * 4;
constexpr int LDS_TOTAL = LDS_CB + 2 * 2048 * 4;
constexpr float SCALE = SM_SCALE;
constexpr float THR = 20.f;
#define KSWZ(row, colB) ((row) * 256 + ((colB) ^ (((row) & 7) << 4)))
#define SBAR() __builtin_amdgcn_sched_barrier(0)
__device__ __forceinline__ int v_st(int k, int c) { const int kk = (k & ~0xC) | ((k & 4) << 1) | ((k & 8) >> 1); return ((kk >> 3) * 4 + (c >> 5)) * 512 + ((kk & 7) * 32 + (c & 31)) * 2; }
__device__ __forceinline__ int v_rd_base(int lane) { return ((lane & 3) << 3) | (((lane >> 2) & 3) << 6) | (((lane >> 4) & 1) << 5) | (((lane >> 5) & 1) << 8); }
constexpr int v_rd_off(int d0, int ks, int half) { return d0 * 512 + ks * 4096 + half * 2048; }
__device__ __forceinline__ int crow(int r, int hi) { return (r & 3) + 8 * (r >> 2) + 4 * hi; }
__device__ __forceinline__ bf16x8 load8(const bf16_t* p) { return *reinterpret_cast<const bf16x8*>(p); }
__device__ __forceinline__ void mask_tile(f32x16& p0, f32x16& p1, int dq) {
    const float NEG = -__builtin_inff();
#pragma unroll
    for (int r = 0; r < 16; ++r) { const int c = (r & 3) + 8 * (r >> 2); if (dq - c < 0) p0[r] = NEG; if (dq - c - 32 < 0) p1[r] = NEG; }
}
__device__ __forceinline__ void bias_tile(f32x16& p0, f32x16& p1, const float* cb) {
    { const f32x4 a0 = *(const f32x4*)(cb), a1 = *(const f32x4*)(cb + 8), a2 = *(const f32x4*)(cb + 16), a3 = *(const f32x4*)(cb + 24);
#pragma unroll
      for (int i = 0; i < 4; ++i) { p0[i] += a0[i]; p0[4 + i] += a1[i]; p0[8 + i] += a2[i]; p0[12 + i] += a3[i]; } }
    asm volatile("" ::: "memory");
    { const f32x4 a0 = *(const f32x4*)(cb + 32), a1 = *(const f32x4*)(cb + 40), a2 = *(const f32x4*)(cb + 48), a3 = *(const f32x4*)(cb + 56);
#pragma unroll
      for (int i = 0; i < 4; ++i) { p1[i] += a0[i]; p1[4 + i] += a1[i]; p1[8 + i] += a2[i]; p1[12 + i] += a3[i]; } }
    asm volatile("" ::: "memory");
}
__device__ __forceinline__ void partialSM(f32x16& p0, f32x16& p1, float& m_reg, float& mn, float& alpha) {
    float pmax = p0[0]; for (int r = 1; r < 16; ++r) pmax = fmaxf(pmax, p0[r]); for (int r = 0; r < 16; ++r) pmax = fmaxf(pmax, p1[r]);
    { auto rr = __builtin_amdgcn_permlane32_swap(__float_as_uint(pmax), __float_as_uint(pmax), false, false);
      pmax = fmaxf(__uint_as_float(rr[0]), __uint_as_float(rr[1])); }
    constexpr float C2 = 1.4426950408889634f * SCALE;
    if (__builtin_expect(__all((pmax - m_reg) * SCALE <= THR), 1)) { mn = m_reg; alpha = 1.f; }
    else { mn = fmaxf(m_reg, pmax); alpha = __builtin_amdgcn_exp2f((m_reg - mn) * C2); m_reg = mn; }
    const float mnL = -mn * C2;
    for (int r = 0; r < 16; ++r) p0[r] = fmaf(p0[r], C2, mnL); for (int r = 0; r < 16; ++r) p1[r] = fmaf(p1[r], C2, mnL);
    for (int r = 0; r < 16; ++r) p0[r] = __builtin_amdgcn_exp2f(p0[r]);
}
__device__ __forceinline__ void finishSM(f32x16& p0, f32x16& p1, float alpha, float& l_reg, bf16x8& pa0, bf16x8& pa1, bf16x8& pa2, bf16x8& pa3) {
    for (int r = 0; r < 16; ++r) p1[r] = __builtin_amdgcn_exp2f(p1[r]);
    float ps = 0; for (int r = 0; r < 16; ++r) ps += p0[r]; for (int r = 0; r < 16; ++r) ps += p1[r];
    { auto rr = __builtin_amdgcn_permlane32_swap(__float_as_uint(ps), __float_as_uint(ps), false, false);
      ps = __uint_as_float(rr[0]) + __uint_as_float(rr[1]); }
    l_reg = l_reg * alpha + ps;
#define PK4(P, B_, OUT) do { unsigned a0 = cvtpk(P[B_+0], P[B_+1]), a1 = cvtpk(P[B_+2], P[B_+3]);                          \
        unsigned b0 = cvtpk(P[B_+4], P[B_+5]), b1 = cvtpk(P[B_+6], P[B_+7]);                                             \
        auto r0 = __builtin_amdgcn_permlane32_swap(a0, b0, false, false); auto r1 = __builtin_amdgcn_permlane32_swap(a1, b1, false, false); \
        u32x4 w = {r0[0], r1[0], r0[1], r1[1]}; OUT = *reinterpret_cast<bf16x8*>(&w); } while (0)
    PK4(p0, 0, pa0); PK4(p0, 8, pa1); PK4(p1, 0, pa2); PK4(p1, 8, pa3);
#undef PK4
}
template <int KB>
__device__ __forceinline__ void qkt(f32x16& p0, f32x16& p1, const char* K_lds, int r32, int hi, const bf16x8* qr, const float* cb  ) {
#pragma unroll
    for (int g = 0; g < 4; ++g) { const f32x4 a = *(const f32x4*)(cb + 8 * g), b = *(const f32x4*)(cb + 32 + 8 * g);
#pragma unroll
        for (int i = 0; i < 4; ++i) { p0[4 * g + i] = a[i]; p1[4 * g + i] = b[i]; } }
    const char* kb[4];
#pragma unroll
    for (int dd = 0; dd < 4; ++dd) kb[dd] = K_lds + KB * SHM_K + KSWZ(r32, (dd * 16 + hi * 8) * 2);
    __builtin_amdgcn_s_setprio(1);
#pragma unroll
    for (int d0 = 0; d0 < 8; ++d0) { const char* a = kb[d0 & 3] + (d0 >> 2) * 128;
        bf16x8 b0 = *reinterpret_cast<const bf16x8*>(a);
        bf16x8 b1 = *reinterpret_cast<const bf16x8*>(a + 32 * 256);
        p0 = __builtin_amdgcn_mfma_f32_32x32x16_bf16(b0, qr[d0], p0, 0, 0, 0);
        p1 = __builtin_amdgcn_mfma_f32_32x32x16_bf16(b1, qr[d0], p1, 0, 0, 0); }
    __builtin_amdgcn_s_setprio(0);
}
template <int VB>
__device__ __forceinline__ void pv_tile(f32x16* o, int vb0, bf16x8 pa0, bf16x8 pa1, bf16x8 pa2, bf16x8 pa3) {
#define TRRD(dst, off) asm volatile("ds_read_b64_tr_b16 %0, %1 offset:%2" : "=&v"(dst) : "v"(vb0), "i"(off) : "memory")
#define PV_D0(d0) do { s16x4 l0, l1, l2, l3, h0, h1, h2, h3; constexpr int b_ = VB * SHM_V + v_rd_off(d0, 0, 0); \
        TRRD(l0, b_); TRRD(h0, b_ + 2048); TRRD(l1, b_ + 4096); TRRD(h1, b_ + 6144); TRRD(l2, b_ + 8192); TRRD(h2, b_ + 10240); TRRD(l3, b_ + 12288); TRRD(h3, b_ + 14336); \
        asm volatile("s_waitcnt lgkmcnt(0)" ::: "memory"); SBAR();   \
        o[d0] = __builtin_amdgcn_mfma_f32_32x32x16_bf16(pa0, (bf16x8){l0[0], l0[1], l0[2], l0[3], h0[0], h0[1], h0[2], h0[3]}, o[d0], 0, 0, 0);   \
        o[d0] = __builtin_amdgcn_mfma_f32_32x32x16_bf16(pa1, (bf16x8){l1[0], l1[1], l1[2], l1[3], h1[0], h1[1], h1[2], h1[3]}, o[d0], 0, 0, 0);   \
        o[d0] = __builtin_amdgcn_mfma_f32_32x32x16_bf16(pa2, (bf16x8){l2[0], l2[1], l2[2], l2[3], h2[0], h2[1], h2[2], h2[3]}, o[d0], 0, 0, 0);   \
        o[d0] = __builtin_amdgcn_mfma_f32_32x32x16_bf16(pa3, (bf16x8){l3[0], l3[1], l3[2], l3[3], h3[0], h3[1], h3[2], h3[3]}, o[d0], 0, 0, 0); } while (0)
    __builtin_amdgcn_s_setprio(1); PV_D0(0); PV_D0(1); PV_D0(2); PV_D0(3); __builtin_amdgcn_s_setprio(0);
#undef PV_D0
#undef TRRD
}
struct BlockRef { const bf16_t* Q; const bf16_t* K; const bf16_t* V; bf16_t* O; int P0; };
struct NextCtx { unsigned* ctr; int* s_item; const bf16_t* Qb; const bf16_t* Kb; const bf16_t* Vb; bf16_t* Ob; const float* cb; int nit; int xcd; };
__device__ __forceinline__ int decode_item(int li, int xcd) {
    if (li < 8) return li * 8 + xcd;
    if (li < 72) { const int k = li - 8, qb = 7 - (k >> 3), bh = (k & 7) * 8 + xcd; return 64 + (7 - qb) * 64 + bh; }
    return 2048 + (li - 72) * 8 + xcd;
}
__device__ __forceinline__ BlockRef item_ref(const NextCtx& nc, int it) {
    const int k = it - 64, qb = 7 - (k >> 6), bh = k & 63; const size_t rb = (size_t)(bh >> 3) * SEQ; const int h = bh & 7;
    BlockRef r; const size_t hb = (size_t)bh * SEQ * HD;
    r.Q = nc.Qb + hb + (size_t)qb * 256 * HD; r.K = nc.Kb + hb; r.V = nc.Vb + hb; r.O = nc.Ob + (rb + qb * 256) * DM + h * HD; r.P0 = qb * 256; return r;
}
__device__ __forceinline__ const float* item_cb(const NextCtx& nc, int it) { return nc.cb + (size_t)((it - 64) & 63) * SEQ; }
struct Seam { bf16x8 qr[8]; bf16x8 st_v0, st_v1, st_k0, st_k1; };
#define ROW(p, k0, rr) ((p) + (size_t)((k0) + (rr)) * LD + sc)
#define VMW() asm volatile("s_waitcnt vmcnt(0)" ::: "memory")
#define VMWN(n) asm volatile("s_waitcnt vmcnt(%0)" :: "i"(n) : "memory")
#define SLOAD_H(Kp, Vp, k0) do { S.st_v0 = load8(ROW(Vp, k0, sr)); S.st_v1 = load8(ROW(Vp, k0, 32 + sr));              \
                         S.st_k0 = load8(ROW(Kp, k0, sr)); S.st_k1 = load8(ROW(Kp, k0, 32 + sr)); } while (0)
#define SWRITE_HK(bf) do { *(bf16x8*)(K_lds + (bf) * SHM_K + kws) = S.st_k0; *(bf16x8*)(K_lds + (bf) * SHM_K + kws + 32 * 256) = S.st_k1; } while (0)
#define SWRITE_HV(bf) do { *(bf16x8*)(V_lds + (bf) * SHM_V + vst0) = S.st_v0; *(bf16x8*)(V_lds + (bf) * SHM_V + vst1) = S.st_v1; } while (0)
#define SWRITE_H(bf) do { SWRITE_HV(bf); SWRITE_HK(bf); } while (0)
__device__ __forceinline__ void attn_prime(const BlockRef& cur, char* lds, Seam& S) {
    const int tid = otid(), wid = __builtin_amdgcn_readfirstlane(tid >> 6), lane = tid & 63, r32 = lane & 31, hi = lane >> 5;
    const int sr = tid >> 4, sc = (tid & 15) * 8, kws = KSWZ(sr, sc * 2); char* K_lds = lds + 2 * SHM_V;
    for (int d0 = 0; d0 < 8; ++d0) S.qr[d0] = load8(cur.Q + (size_t)(wid * QBLK + r32) * LD + d0 * 16 + hi * 8);
    SLOAD_H(cur.K, cur.V, 0); VMW(); SWRITE_HK(0);
    __syncthreads();
}
__device__ __forceinline__ void attn_block(const BlockRef& cur, char* lds, Seam& S, int cbsel, const NextCtx& nc, int& itn  ) {
    const int tid = otid(), wid = __builtin_amdgcn_readfirstlane(tid >> 6), lane = tid & 63, r32 = lane & 31, hi = lane >> 5;
    const int NT = (cur.P0 + QB) / KVBLK;
    const int qlo = cur.P0 + wid * QBLK, qm = qlo + r32 - 4 * hi;
    char* V_lds = lds; char* K_lds = lds + 2 * SHM_V;
    float* ws = (float*)(lds + LDS_WS) + wid * 64; float* li_l = ws, * al_l = ws + 32;
    const float* cbl = (const float*)(lds + LDS_CB + cbsel * 8192) + 4 * hi;
    float m_reg = -1e30f, l_reg = 0; f32x16 o[4] = {};
    const int sr = tid >> 4, sc = (tid & 15) * 8, vst0 = v_st(sr, sc), vst1 = v_st(32 + sr, sc), kws = KSWZ(sr, sc * 2);
    const int vb0 = (int)(uintptr_t)V_lds + v_rd_base(lane);
    const bf16_t* Kh = cur.K; const bf16_t* Vh = cur.V;
#define RESC(a) do { if (__any((a) < 1.f)) { if (hi == 0) al_l[r32] = (a); asm volatile("s_waitcnt lgkmcnt(0)" ::: "memory");              \
                     for (int d_ = 0; d_ < 4; ++d_) for (int r = 0; r < 16; ++r) o[d_][r] *= al_l[crow(r, hi)]; } } while (0)
#define KBASE(t) ((t) * KVBLK)
#define MASKT(P0_, P1_, t) do { const int kb_ = KBASE(t); if (kb_ + KVBLK - 1 > qlo) mask_tile(P0_, P1_, qm - kb_); } while (0)
    constexpr int NQL = 8;
#define SEAM_K0() do { VMWN(NQL); SWRITE_HK(0); SBAR(); } while (0)
    f32x16 pA0, pA1, pB0, pB1; float mnA, mnB, alA, alB; bf16x8 pa0, pa1, pa2, pa3;
    SWRITE_HV(0); SBAR();
    if (NT > 1) { SLOAD_H(Kh, Vh, KBASE(1)); }
    SBAR(); qkt<0>(pA0, pA1, K_lds, r32, hi, S.qr, cbl);
    MASKT(pA0, pA1, 0); partialSM(pA0, pA1, m_reg, mnA, alA);
    if (NT > 1) { VMW(); SWRITE_H(1); }
    __syncthreads();
#define HALF_STEP(PX0, PX1, mnX, alX, PY0, PY1, alY, t, KB, VB, SB) do {                                                      \
        SBAR(); qkt<KB>(PX0, PX1, K_lds, r32, hi, S.qr, cbl + KBASE(t));                                             \
        if ((t) + 1 < NT) { SLOAD_H(Kh, Vh, KBASE((t) + 1)); SBAR(); }        \
        finishSM(PY0, PY1, alY, l_reg, pa0, pa1, pa2, pa3); SBAR();                                                           \
        pv_tile<VB>(o, vb0, pa0, pa1, pa2, pa3); MASKT(PX0, PX1, (t)); partialSM(PX0, PX1, m_reg, mnX, alX);                                        \
        __syncthreads();                                                                                                      \
        if ((t) + 1 < NT) { VMW(); SWRITE_H(SB); }                                                                          \
        RESC(alX); __syncthreads(); } while (0)
    for (int t = 1; t + 1 < NT; t += 2) {
        HALF_STEP(pB0, pB1, mnB, alB, pA0, pA1, alA, t, 1, 0, 0);
        HALF_STEP(pA0, pA1, mnA, alA, pB0, pB1, alB, t + 1, 0, 1, 1);
    }
    if (tid == 0) *nc.s_item = (int)atomicAdd(nc.ctr, 1u);
    __syncthreads(); itn = __builtin_amdgcn_readfirstlane(decode_item(*nc.s_item, nc.xcd)); __syncthreads();
    const bool more = itn >= 64 && itn < nc.nit;
    const BlockRef nxt = more ? item_ref(nc, itn) : cur; const float* nxt_cb = item_cb(nc, more ? itn : 64);
    if (more && wid * 256 < nxt.P0 + QB)
        __builtin_amdgcn_global_load_lds((const unsigned*)(nxt_cb + tid * 4), (LAS unsigned*)(LAS char*)(lds + LDS_CB + (cbsel ^ 1) * 8192 + wid * 1024), 16, 0, 0);
    const bool even = (NT & 1) == 0;
    if (even) { SBAR(); qkt<1>(pB0, pB1, K_lds, r32, hi, S.qr, cbl + KBASE(NT - 1)); SBAR(); }
    SLOAD_H(nxt.K, nxt.V, 0); SBAR();
#pragma unroll
    for (int d0 = 0; d0 < 8; ++d0) S.qr[d0] = load8(nxt.Q + (size_t)(wid * QBLK + r32) * LD + d0 * 16 + hi * 8);
    SBAR();
    finishSM(pA0, pA1, alA, l_reg, pa0, pa1, pa2, pa3); SBAR();
    pv_tile<0>(o, vb0, pa0, pa1, pa2, pa3);
    if (even) { MASKT(pB0, pB1, NT - 1); partialSM(pB0, pB1, m_reg, mnB, alB); __syncthreads(); RESC(alB);
        finishSM(pB0, pB1, alB, l_reg, pa0, pa1, pa2, pa3); SBAR(); pv_tile<1>(o, vb0, pa0, pa1, pa2, pa3); }
    SBAR(); SEAM_K0();
    if (hi == 0) li_l[r32] = l_reg; asm volatile("s_waitcnt lgkmcnt(0)" ::: "memory");
    float rli[16];
#pragma unroll
    for (int r = 0; r < 16; ++r) rli[r] = __builtin_amdgcn_rcpf(li_l[crow(r, hi)]);
    bf16_t* Ow = cur.O + (size_t)(wid * QBLK) * LDO;
#pragma unroll
    for (int r = 0; r < 16; ++r) { const int orow = crow(r, hi);
#pragma unroll
        for (int d0 = 0; d0 < 4; ++d0) { const float v = o[d0][r] * rli[r];
            const float vn = __shfl_xor(v, 1);
            if ((r32 & 1) == 0) *(unsigned*)(Ow + (size_t)orow * LDO + d0 * 32 + r32) = cvtpk(v, vn); } }
    __syncthreads();
#undef RESC
#undef KBASE
#undef MASKT
#undef SEAM_K0
#undef HALF_STEP
}
#undef ROW
#undef VMW
#undef VMWN
#undef SLOAD_H
#undef SWRITE_HK
#undef SWRITE_HV
#undef SWRITE_H
}

namespace gdn {
constexpr int RS = 136;
constexpr int TS = 72;
constexpr int AS = 68;
constexpr int L_RAW = 0;
constexpr int L_KBT = 0, L_VBT = 18432;
constexpr int L_QR = 54784, L_KR = 72192;
constexpr int L_A = 89600;
constexpr int L_TB = 107008;
constexpr int L_G = 116224, L_BETA = 116480;
constexpr int L_SSQ = 116736;
constexpr int L_WC = 126976;
constexpr int L_AB = 120832, L_TT = 123392, XS = 40;
__device__ __forceinline__ int crow(int r, int hi) { return (r & 3) + 8 * (r >> 2) + 4 * hi; }

__device__ __forceinline__ void raw_load(u32x4 (&rv)[7], int uidx, int tid, const bf16_t* gq, const bf16_t* gk, const bf16_t* gv) {
    const int h = uidx & 7, n = (uidx >> 3) & 31, bl = uidx >> 8; const int t0 = n * 64; const size_t rowb = (size_t)bl * SEQ;
#pragma unroll
    for (int k = 0; k < 7; ++k) { const int idx = tid + 512 * k;
        const int ten = idx / (67 * 16), rem = idx - ten * (67 * 16), row = rem >> 4, seg = rem & 15; const int t = t0 - 3 + row;
        const bf16_t* src = ten == 0 ? gq : (ten == 1 ? gk : gv);
        rv[k] = (u32x4){0u, 0u, 0u, 0u};
        if (idx < 3 * 67 * 16 && t >= 0) rv[k] = *(const u32x4*)(src + (rowb + t) * DM + h * HD + seg * 8); }
}
__device__ __forceinline__ void intra_unit(unsigned char* lds, int uidx, int unext, u32x4 (&rv)[7], int& hprev, int half, const bf16_t* gq, const bf16_t* gk, const bf16_t* gv, const float* small,
                           const float* conv_w, const float* a_log, const float* dt_bias, unsigned char* io, float* decg) {
    const int tid = otid(), lane = tid & 63, wid = __builtin_amdgcn_readfirstlane(tid >> 6), r32 = lane & 31, hi = lane >> 5;
    const int h = uidx & 7, n = (uidx >> 3) & 31, bl = uidx >> 8;
    const int t0 = n * 64; const size_t rowb = (size_t)bl * SEQ;
    const int ch = (bl * NH + h) * NCH + n;
    unsigned char* iob = io + (size_t)ch * IO_STRIDE;
    bf16_t* RAW = (bf16_t*)(lds + L_RAW);
    float* GS = (float*)(lds + L_G); float* BS = (float*)(lds + L_BETA); float* SSQ = (float*)(lds + L_SSQ);
    {
#pragma unroll
        for (int k = 0; k < 7; ++k) { const int idx = tid + 512 * k;
            const int ten = idx / (67 * 16), rem = idx - ten * (67 * 16), row = rem >> 4, seg = rem & 15;
            if (idx < 3 * 67 * 16) *(u32x4*)(RAW + (ten * 67 + row) * RS + seg * 8) = rv[k]; }
    }
    if (h != hprev) {
        float* WC = (float*)(lds + L_WC);
#pragma unroll
        for (int k = 0; k < 3; ++k) { const int j = tid + 512 * k, ten = j >> 9, tap = (j >> 7) & 3, d = j & 127; WC[j] = conv_w[(size_t)tap * 3072 + ten * 1024 + h * HD + d]; }
        hprev = h; }
    if (tid < 64) {
        const size_t grow = (size_t)half * MH + rowb + t0 + tid;
        const float ga = small[grow * 24 + h], gb = small[grow * 24 + 8 + h];
        const float xs = ga + dt_bias[h]; const float sp = xs > 20.f ? xs : log1pf(__expf(xs));
        float g = -__expf(a_log[h]) * sp;
#pragma unroll
        for (int o = 1; o < 64; o <<= 1) { const float up = __shfl_up(g, o); if (lane >= o) g += up; }
        GS[tid] = g; BS[tid] = sigmoidf_(gb);
    }
    LBAR();
    float yq[2][8], yk[2][8], yv[2][8]; float sq = 0.f, sk = 0.f;
#pragma unroll
    for (int bi = 0; bi < 2; ++bi) { const int d0 = (wid + 8 * bi) * 8;
#pragma unroll
        for (int ten = 0; ten < 3; ++ten) { float a[8];
#pragma unroll
            for (int i = 0; i < 8; ++i) a[i] = 0.f;
#pragma unroll
            for (int tap = 0; tap < 4; ++tap) { const u32x4 xr = *(const u32x4*)(RAW + (ten * 67 + lane + tap) * RS + d0);
                const float* wp = (const float*)(lds + L_WC) + (ten * 4 + tap) * 128 + d0; const f32x4 w0 = *(const f32x4*)wp, w1 = *(const f32x4*)(wp + 4);
                a[0] += w0[0] * bflo(xr.x); a[1] += w0[1] * bfhi(xr.x); a[2] += w0[2] * bflo(xr.y); a[3] += w0[3] * bfhi(xr.y);
                a[4] += w1[0] * bflo(xr.z); a[5] += w1[1] * bfhi(xr.z); a[6] += w1[2] * bflo(xr.w); a[7] += w1[3] * bfhi(xr.w); }
#pragma unroll
            for (int i = 0; i < 8; ++i) { const float y = siluf_(a[i]); if (ten == 0) { yq[bi][i] = y; sq += y * y; } else if (ten == 1) { yk[bi][i] = y; sk += y * y; } else yv[bi][i] = y; } } }
    SSQ[wid * 64 + lane] = sq; SSQ[512 + wid * 64 + lane] = sk;
    LBAR();
    {
        float tq = 0.f, tk = 0.f;
#pragma unroll
        for (int w = 0; w < 8; ++w) { tq += SSQ[w * 64 + lane]; tk += SSQ[512 + w * 64 + lane]; }
        const float rq = SM_SCALE * __builtin_amdgcn_rsqf(tq + EPS), rk = __builtin_amdgcn_rsqf(tk + EPS);
        const float G = GS[lane], beta = BS[lane], Gl = GS[63];
        const float eG = __expf(G), ekd = __expf(Gl - G), bE = beta * eG;
        bf16_t* QR = (bf16_t*)(lds + L_QR); bf16_t* KR = (bf16_t*)(lds + L_KR); bf16_t* KBT = (bf16_t*)(lds + L_KBT); bf16_t* VBT = (bf16_t*)(lds + L_VBT);
        bf16_t* gQd = (bf16_t*)(iob + IO_QD); bf16_t* gKdT = (bf16_t*)(iob + IO_KDT);
#pragma unroll
        for (int bi = 0; bi < 2; ++bi) { const int d0 = (wid + 8 * bi) * 8; float qn[8], kn[8];
#pragma unroll
            for (int i = 0; i < 8; ++i) { qn[i] = yq[bi][i] * rq; kn[i] = yk[bi][i] * rk; }
            u32x4 w;
            w.x = cvtpk(qn[0], qn[1]); w.y = cvtpk(qn[2], qn[3]); w.z = cvtpk(qn[4], qn[5]); w.w = cvtpk(qn[6], qn[7]); *(u32x4*)(QR + lane * RS + d0) = w;
            w.x = cvtpk(kn[0], kn[1]); w.y = cvtpk(kn[2], kn[3]); w.z = cvtpk(kn[4], kn[5]); w.w = cvtpk(kn[6], kn[7]); *(u32x4*)(KR + lane * RS + d0) = w;
            w.x = cvtpk(qn[0] * eG, qn[1] * eG); w.y = cvtpk(qn[2] * eG, qn[3] * eG); w.z = cvtpk(qn[4] * eG, qn[5] * eG); w.w = cvtpk(qn[6] * eG, qn[7] * eG);
            *(u32x4*)(gQd + lane * HD + d0) = w;
#pragma unroll
            for (int i = 0; i < 8; ++i) { KBT[(d0 + i) * TS + lane] = f2bf(kn[i] * bE); VBT[(d0 + i) * TS + lane] = f2bf(yv[bi][i] * beta); gKdT[(d0 + i) * 64 + lane] = f2bf(kn[i] * ekd); } }
        if (tid == 0) decg[ch] = __expf(Gl);
    }
    LBAR();
    {
        const int type = wid >> 2, it = (wid >> 1) & 1, jt = wid & 1;
        bf16_t* gAt = (bf16_t*)(iob + IO_AT); float* Af = (float*)(lds + L_A);
        const int j = 32 * jt + r32; const float Gj = GS[j];
        if (it == 0 && jt == 1) {
            if (type == 1) {
#pragma unroll
                for (int r = 0; r < 16; ++r) gAt[(crow(r, hi)) * 64 + j] = 0;
            }
        } else {
            const bf16_t* Ab = (const bf16_t*)(lds + (type ? L_QR : L_KR)) + (32 * it + r32) * RS + 8 * hi;
            const bf16_t* Bb = (const bf16_t*)(lds + L_KR) + (32 * jt + r32) * RS + 8 * hi;
            f32x16 acc = {};
#pragma unroll
            for (int s = 0; s < 8; ++s) acc = __builtin_amdgcn_mfma_f32_32x32x16_bf16(*(const bf16x8*)(Ab + 16 * s), *(const bf16x8*)(Bb + 16 * s), acc, 0, 0, 0);
            f32x4 Gr[4], Br[4];
#pragma unroll
            for (int g = 0; g < 4; ++g) { Gr[g] = *(const f32x4*)(GS + 32 * it + 8 * g + 4 * hi); Br[g] = *(const f32x4*)(BS + 32 * it + 8 * g + 4 * hi); }
            if (type == 0) {
#pragma unroll
                for (int r = 0; r < 16; ++r) { const int i = 32 * it + crow(r, hi); const float e_ = __expf(fminf(Gr[r >> 2][r & 3] - Gj, 0.f));
                    const float v_ = (i > j) ? Br[r >> 2][r & 3] * acc[r] * e_ : 0.f;
                    if (it == 1 && jt == 0) ((bf16_t*)(lds + L_AB))[(i - 32) * XS + j] = f2bf(v_); else Af[i * AS + j] = v_; }
            } else {
#pragma unroll
                for (int r = 0; r < 16; ++r) { const int i = 32 * it + crow(r, hi); const float e_ = __expf(fminf(Gr[r >> 2][r & 3] - Gj, 0.f));
                    gAt[i * 64 + j] = f2bf((i >= j) ? acc[r] * e_ : 0.f); }
            }
        }
    }
    LBAR();
    if (wid == 0) {
        const int c = lane & 31, hb = lane >> 5;
        LAS const float* Af = (LAS const float*)(lds + L_A) + (hb * 32) * AS + hb * 32;
        LAS bf16_t* TB = (LAS bf16_t*)(lds + L_TB) + (hb * 32) * TS + hb * 32 + c;
        asm volatile("" : "+v"(Af)); asm volatile("" : "+v"(TB));
        float t[32];
        f32x4 rowbuf[2][8];
        t[0] = (c == 0) ? 1.f : 0.f; TB[0] = f2bf(t[0]);
        rowbuf[1][0] = *(LAS const f32x4*)(Af + 1 * AS);
#pragma unroll
        for (int i = 1; i < 32; ++i) {
            if (i + 1 < 32) {
#pragma unroll
                for (int j4 = 0; j4 < (i + 4) / 4; ++j4) rowbuf[(i + 1) & 1][j4] = *(LAS const f32x4*)(Af + (i + 1) * AS + 4 * j4);
            }
            float s0 = (i == c) ? 1.f : 0.f, s1 = 0.f;
            asm volatile("" : "+v"(s0), "+v"(s1) :: "memory");
#pragma unroll
            for (int j4 = 0; j4 < (i + 3) / 4; ++j4) { const f32x4 a = rowbuf[i & 1][j4];
#pragma unroll
                for (int q = 0; q < 4; ++q) if (4 * j4 + q < i) { if (j4 & 1) s1 -= a[q] * t[4 * j4 + q]; else s0 -= a[q] * t[4 * j4 + q]; } }
            const float sv = s0 + s1;
            t[i] = sv; TB[i * TS] = f2bf(sv);
        }
        bf16_t* TT = (bf16_t*)(lds + L_TT); const bf16_t* AB = (const bf16_t*)(lds + L_AB);
        if (hb == 0) {
#pragma unroll
            for (int q = 0; q < 4; ++q) { u32x4 w; w.x = cvtpk(t[8 * q], t[8 * q + 1]); w.y = cvtpk(t[8 * q + 2], t[8 * q + 3]); w.z = cvtpk(t[8 * q + 4], t[8 * q + 5]); w.w = cvtpk(t[8 * q + 6], t[8 * q + 7]);
                *(u32x4*)(TT + c * XS + 8 * q) = w; }
        }
        asm volatile("s_waitcnt lgkmcnt(0)" ::: "memory");
        f32x16 Mx = {};
#pragma unroll
        for (int s2 = 0; s2 < 2; ++s2) Mx = __builtin_amdgcn_mfma_f32_32x32x16_bf16(*(const bf16x8*)(AB + c * XS + 16 * s2 + 8 * hb), *(const bf16x8*)(TT + c * XS + 16 * s2 + 8 * hb), Mx, 0, 0, 0);
        f32x16 Rx = {};
        const bf16_t* T22 = (const bf16_t*)(lds + L_TB) + (32 + c) * TS + 32 + 4 * hb;
#pragma unroll
        for (int s2 = 0; s2 < 2; ++s2) {
            u32x4 w = {cvtpk(Mx[8 * s2], Mx[8 * s2 + 1]), cvtpk(Mx[8 * s2 + 2], Mx[8 * s2 + 3]), cvtpk(Mx[8 * s2 + 4], Mx[8 * s2 + 5]), cvtpk(Mx[8 * s2 + 6], Mx[8 * s2 + 7])};
            const u32x2 a0 = *(const u32x2*)(T22 + 16 * s2), a1 = *(const u32x2*)(T22 + 16 * s2 + 8); u32x4 av = {a0.x, a0.y, a1.x, a1.y};
            Rx = __builtin_amdgcn_mfma_f32_32x32x16_bf16(__builtin_bit_cast(bf16x8, av), __builtin_bit_cast(bf16x8, w), Rx, 0, 0, 0); }
        bf16_t* T21 = (bf16_t*)(lds + L_TB) + 32 * TS + c;
#pragma unroll
        for (int r = 0; r < 16; ++r) T21[crow(r, hb) * TS] = f2bf(-Rx[r]);
        raw_load(rv, unext, tid, gq, gk, gv);
    } else {
        raw_load(rv, unext, tid, gq, gk, gv);
    }
    LBAR();
    {
        const bf16_t* TB = (const bf16_t*)(lds + L_TB);
        bf16_t* gUT = (bf16_t*)(iob + IO_UT); bf16_t* gWn = (bf16_t*)(iob + IO_WN);
#pragma unroll
        for (int qi = 0; qi < 2; ++qi) { const int q = wid * 2 + qi, type = q >> 3, it = (q >> 2) & 1, et = q & 3;
            const bf16_t* Ab = TB + (32 * it + r32) * TS + 8 * hi;
            const bf16_t* Bb = (const bf16_t*)(lds + (type ? L_KBT : L_VBT)) + (32 * et + r32) * TS + 8 * hi;
            f32x16 acc = {};
            const int ns = it ? 4 : 2;
            for (int s = 0; s < ns; ++s) acc = __builtin_amdgcn_mfma_f32_32x32x16_bf16(*(const bf16x8*)(Ab + 16 * s), *(const bf16x8*)(Bb + 16 * s), acc, 0, 0, 0);
            const int e = 32 * et + r32;
            if (type == 0) {
#pragma unroll
                for (int g = 0; g < 4; ++g) { u32x2 w; w.x = cvtpk(acc[4 * g], acc[4 * g + 1]); w.y = cvtpk(acc[4 * g + 2], acc[4 * g + 3]);
                    *(u32x2*)(gUT + e * 64 + 32 * it + 8 * g + 4 * hi) = w; }
            } else {
#pragma unroll
                for (int r = 0; r < 16; ++r) gWn[(32 * it + crow(r, hi)) * HD + e] = f2bf(-acc[r]);
            } }
    }
    LBAR();
}

constexpr int SB_WN = 0, SB_QD = 17408, SB_KDT = 34816, SB_AT = 53248, SB_SIZE = 62464;
__device__ __forceinline__ bf16x8 packb(f32x4 a, f32x4 b) { u32x4 w = {cvtpk(a[0], a[1]), cvtpk(a[2], a[3]), cvtpk(b[0], b[1]), cvtpk(b[2], b[3])}; return __builtin_bit_cast(bf16x8, w); }
__device__ __forceinline__ bf16x8 afrag(const bf16_t* p) { return *(const bf16x8*)p; }
__device__ void scan_unit(unsigned char* lds, int bh, const unsigned char* io, const float* decg, bf16_t* oa  , const bf16_t* gz, const float* gng) {
    const int tid = otid(), lane = tid & 63, wid = __builtin_amdgcn_readfirstlane(tid >> 6), fr = lane & 15, fq = lane >> 4;
    const int bl = bh >> 3, h = bh & 7;
    const unsigned char* iob = io + (size_t)bh * NCH * IO_STRIDE;
    u32x4 stA[7], stB[7];
#define SC_LOAD(st, nn) do { const unsigned char* b_ = iob + (size_t)(nn) * IO_STRIDE; \
        st[0] = *(const u32x4*)(b_ + IO_WN + tid * 16); st[1] = *(const u32x4*)(b_ + IO_WN + 8192 + tid * 16); \
        st[2] = *(const u32x4*)(b_ + IO_QD + tid * 16); st[3] = *(const u32x4*)(b_ + IO_QD + 8192 + tid * 16); \
        st[4] = *(const u32x4*)(b_ + IO_KDT + tid * 16); st[5] = *(const u32x4*)(b_ + IO_KDT + 8192 + tid * 16); \
        st[6] = *(const u32x4*)(b_ + IO_AT + tid * 16); } while (0)
#define SC_PERM(j) (32 * ((j) >> 2) + 16 * ((j) & 1) + 4 * (((j) >> 1) & 1))
#define SC_W16(base, rowstride, row, j, v) do { unsigned char* d_ = (base) + ((row) * (rowstride) + SC_PERM(j)) * 2; *(u32x2*)d_ = (u32x2){(v).x, (v).y}; *(u32x2*)(d_ + 16) = (u32x2){(v).z, (v).w}; } while (0)
#define SC_WRITE(st, bufi) do { unsigned char* l_ = lds + (bufi) * SB_SIZE; \
        { const int p = tid; SC_W16(l_ + SB_WN, RS, p >> 4, p & 15, st[0]); SC_W16(l_ + SB_QD, RS, p >> 4, p & 15, st[2]); \
          SC_W16(l_ + SB_KDT, TS, p >> 3, p & 7, st[4]); SC_W16(l_ + SB_AT, TS, p >> 3, p & 7, st[6]); } \
        { const int p = tid + 512; SC_W16(l_ + SB_WN, RS, p >> 4, p & 15, st[1]); SC_W16(l_ + SB_QD, RS, p >> 4, p & 15, st[3]); \
          SC_W16(l_ + SB_KDT, TS, p >> 3, p & 7, st[5]); } } while (0)
    f32x4 S[8];
#pragma unroll
    for (int i = 0; i < 8; ++i) S[i] = (f32x4){0.f, 0.f, 0.f, 0.f};
    SC_LOAD(stA, 0); SC_WRITE(stA, 0); SC_LOAD(stB, 1); SC_LOAD(stA, 2);
    const int e = 16 * wid + fr;
    constexpr int SB_OT = 2 * SB_SIZE, OT_SIZE = 64 * RS * 2;
    const int nrow = tid >> 3, ncs = (tid & 7) * 16;
    float* gnl = (float*)(lds + SB_OT + 2 * OT_SIZE);
    if (tid < 128) gnl[tid] = gng[tid];
    const int zoff = (bl * SEQ + nrow) * DM + h * HD + ncs;
    u32x4 zc0 = {0u, 0u, 0u, 0u}, zc1 = zc0, zn0 = zc0, zn1 = zc0;
#define SC_NORM(nn, Z0, Z1) do { const bf16_t* ot_ = (const bf16_t*)(lds + SB_OT + ((nn) & 1) * OT_SIZE) + nrow * RS + ncs; \
        const u32x4 x0 = *(const u32x4*)ot_, x1 = *(const u32x4*)(ot_ + 8); \
        float f[16] = {bflo(x0.x), bfhi(x0.x), bflo(x0.y), bfhi(x0.y), bflo(x0.z), bfhi(x0.z), bflo(x0.w), bfhi(x0.w), \
                       bflo(x1.x), bfhi(x1.x), bflo(x1.y), bfhi(x1.y), bflo(x1.z), bfhi(x1.z), bflo(x1.w), bfhi(x1.w)}; \
        float z[16] = {bflo(Z0.x), bfhi(Z0.x), bflo(Z0.y), bfhi(Z0.y), bflo(Z0.z), bfhi(Z0.z), bflo(Z0.w), bfhi(Z0.w), \
                       bflo(Z1.x), bfhi(Z1.x), bflo(Z1.y), bfhi(Z1.y), bflo(Z1.z), bfhi(Z1.z), bflo(Z1.w), bfhi(Z1.w)}; \
        float ss = 0.f; _Pragma("unroll") for (int i = 0; i < 16; ++i) ss += f[i] * f[i]; \
        ss += __shfl_xor(ss, 1); ss += __shfl_xor(ss, 2); ss += __shfl_xor(ss, 4); \
        const float rstd = __builtin_amdgcn_rsqf(ss * (1.f / HD) + EPS); \
        _Pragma("unroll") for (int q = 0; q < 4; ++q) { const f32x4 g4 = *(const f32x4*)(gnl + ncs + 4 * q); \
            _Pragma("unroll") for (int i = 0; i < 4; ++i) f[4 * q + i] = f[4 * q + i] * rstd * g4[i] * siluf_(z[4 * q + i]); } \
        u32x4 y0, y1; y0.x = cvtpk(f[0], f[1]); y0.y = cvtpk(f[2], f[3]); y0.z = cvtpk(f[4], f[5]); y0.w = cvtpk(f[6], f[7]); \
        y1.x = cvtpk(f[8], f[9]); y1.y = cvtpk(f[10], f[11]); y1.z = cvtpk(f[12], f[13]); y1.w = cvtpk(f[14], f[15]); \
        bf16_t* op_ = oa + (zoff + (nn) * 64 * DM); *(u32x4*)op_ = y0; *(u32x4*)(op_ + 8) = y1; } while (0)
    u32x2 un[4]; float decn;
    { const bf16_t* ut = (const bf16_t*)(iob + IO_UT) + e * 64 + 4 * fq;
#pragma unroll
      for (int tt = 0; tt < 4; ++tt) un[tt] = *(const u32x2*)(ut + 16 * tt);
      decn = decg[bh * NCH]; }
    LBAR();
    for (int n2 = 0; n2 < NCH; n2 += 2) {
#pragma unroll
    for (int par = 0; par < 2; ++par) { const int n = n2 + par;
        const unsigned char* L = lds + (n & 1) * SB_SIZE;
        f32x4 vn[4], o[4]; const float dec = decn;
#pragma unroll
        for (int tt = 0; tt < 4; ++tt) { vn[tt] = (f32x4){bflo(un[tt].x), bfhi(un[tt].x), bflo(un[tt].y), bfhi(un[tt].y)}; o[tt] = (f32x4){0.f, 0.f, 0.f, 0.f}; }
        if (n + 1 < NCH) {
            const bf16_t* ut = (const bf16_t*)(iob + (size_t)(n + 1) * IO_STRIDE + IO_UT) + e * 64 + 4 * fq;
#pragma unroll
            for (int tt = 0; tt < 4; ++tt) un[tt] = *(const u32x2*)(ut + 16 * tt);
            decn = decg[bh * NCH + n + 1]; }
        zn0 = *(const u32x4*)(gz + (zoff + n * 64 * DM)); zn1 = *(const u32x4*)(gz + (zoff + n * 64 * DM + 8));
        if (n > 0) SC_NORM(n - 1, zc0, zc1);
        zc0 = zn0; zc1 = zn1;
        bf16x8 Sb[4];
#pragma unroll
        for (int k = 0; k < 4; ++k) Sb[k] = packb(S[2 * k], S[2 * k + 1]);
        const bf16_t* Wn = (const bf16_t*)(L + SB_WN) + fr * RS + 8 * fq; const bf16_t* Qd = (const bf16_t*)(L + SB_QD) + fr * RS + 8 * fq;
        const bf16_t* At = (const bf16_t*)(L + SB_AT) + fr * TS + 8 * fq; const bf16_t* Kd = (const bf16_t*)(L + SB_KDT) + fr * TS + 8 * fq;
        bf16x8 fa[2][4];
#define SC_LD4(buf, p0, p1, p2, p3) do { fa[buf][0] = afrag(p0); fa[buf][1] = afrag(p1); fa[buf][2] = afrag(p2); fa[buf][3] = afrag(p3); } while (0)
#define SC_LDG4(g, buf) do { \
        if ((g) < 8) { const int tt_ = (g) >> 1, k0_ = 2 * ((g) & 1); SC_LD4(buf, Wn + 16 * tt_ * RS + 32 * k0_, Qd + 16 * tt_ * RS + 32 * k0_, Wn + 16 * tt_ * RS + 32 * (k0_ + 1), Qd + 16 * tt_ * RS + 32 * (k0_ + 1)); } \
        else if ((g) < 10) { const int t0_ = 2 * ((g) - 8); SC_LD4(buf, At + 16 * t0_ * TS, At + 16 * (t0_ + 1) * TS, At + 16 * t0_ * TS + 32, At + 16 * (t0_ + 1) * TS + 32); } \
        else { const int d0_ = 2 * ((g) - 10); SC_LD4(buf, Kd + 16 * d0_ * TS, Kd + 16 * (d0_ + 1) * TS, Kd + 16 * d0_ * TS + 32, Kd + 16 * (d0_ + 1) * TS + 32); } } while (0)
#define SC_MMA(acc, A, B) acc = __builtin_amdgcn_mfma_f32_16x16x32_bf16(A, B, acc, 0, 0, 0)
        SC_LDG4(0, 0);
#pragma unroll
        for (int g = 0; g < 8; ++g) { const int tt = g >> 1, k0 = 2 * (g & 1);
            SC_LDG4(g + 1, (g + 1) & 1);
            asm volatile("" : "+v"(vn[tt]), "+v"(o[tt]) :: "memory");
            SC_MMA(vn[tt], fa[g & 1][0], Sb[k0]); SC_MMA(o[tt], fa[g & 1][1], Sb[k0]); SC_MMA(vn[tt], fa[g & 1][2], Sb[k0 + 1]); SC_MMA(o[tt], fa[g & 1][3], Sb[k0 + 1]); }
        bf16x8 vb[2];
        vb[0] = packb(vn[0], vn[1]); vb[1] = packb(vn[2], vn[3]);
#pragma unroll
        for (int g = 8; g < 10; ++g) { const int t0 = 2 * (g - 8);
            SC_LDG4(g + 1, (g + 1) & 1);
            asm volatile("" : "+v"(o[t0]), "+v"(o[t0 + 1]) :: "memory");
            SC_MMA(o[t0], fa[g & 1][0], vb[0]); SC_MMA(o[t0 + 1], fa[g & 1][1], vb[0]); SC_MMA(o[t0], fa[g & 1][2], vb[1]); SC_MMA(o[t0 + 1], fa[g & 1][3], vb[1]); }
#pragma unroll
        for (int dt = 0; dt < 8; ++dt) S[dt] = S[dt] * dec;
#pragma unroll
        for (int g = 10; g < 14; ++g) { const int d0 = 2 * (g - 10);
            if (g < 13) SC_LDG4(g + 1, (g + 1) & 1);
            asm volatile("" : "+v"(S[d0]), "+v"(S[d0 + 1]) :: "memory");
            SC_MMA(S[d0], fa[g & 1][0], vb[0]); SC_MMA(S[d0 + 1], fa[g & 1][1], vb[0]); SC_MMA(S[d0], fa[g & 1][2], vb[1]); SC_MMA(S[d0 + 1], fa[g & 1][3], vb[1]); }
#undef SC_LDG4
#undef SC_LD4
#undef SC_MMA
        { bf16_t* ot = (bf16_t*)(lds + SB_OT + (n & 1) * OT_SIZE) + (4 * fq) * RS + e;
#pragma unroll
          for (int tt = 0; tt < 4; ++tt)
#pragma unroll
              for (int i = 0; i < 4; ++i) ot[(16 * tt + i) * RS] = f2bf(o[tt][i]); }
        if (n + 1 < NCH) { if (par == 0) SC_WRITE(stB, 1); else SC_WRITE(stA, 0); }
        if (n + 3 < NCH) { if (par == 0) SC_LOAD(stB, n + 3); else SC_LOAD(stA, n + 3); }
        LBAR();
    } }
    SC_NORM(NCH - 1, zc0, zc1);
    LBAR();
#undef SC_NORM
#undef SC_LOAD
#undef SC_WRITE
}
}

#define XB_TMO      128
#define XB_XCNT(j)  (256  + 64 * (j))
#define XB_XSUB(j)  (1280 + 64 * (j))
#define XB_XGEN(j)  (2304 + 64 * (j))
#define XB_TOP      3328
#define XB_TOPGEN   3392
#define XCD_BAR_WORDS 3456
#define XB_SPIN_CAP (1u << 22)
__device__ __forceinline__ unsigned xb_ld(unsigned* p)              { return __hip_atomic_load(p, __ATOMIC_RELAXED, __HIP_MEMORY_SCOPE_AGENT); }
__device__ __forceinline__ unsigned xb_add(unsigned* p, unsigned v) { return __hip_atomic_fetch_add(p, v, __ATOMIC_RELAXED, __HIP_MEMORY_SCOPE_AGENT); }
__device__ __forceinline__ unsigned xb_xcc_id() { return (unsigned)__builtin_amdgcn_s_getreg((3 << 11) | 20) & 0xFu; }
#define XB_SPIN(cond, bar) do { unsigned _sp = 0; while (cond) { __builtin_amdgcn_s_sleep(1); \
    if ((++_sp & 255u) == 0u) { if (xb_ld(&(bar)[XB_TMO])) break; if (_sp > XB_SPIN_CAP) { atomicAdd(&(bar)[XB_TMO], 1u); break; } } } } while (0)
struct XcdBarrier { unsigned* bar; unsigned x; volatile LAS unsigned* st; };
__device__ __forceinline__ XcdBarrier xcd_barrier_post(unsigned* bar, volatile LAS unsigned* st) {
    XcdBarrier b; b.bar = bar; b.x = xb_xcc_id(); b.st = st;
    if (threadIdx.x == 0) (void)xb_add(&bar[XB_XCNT(b.x)], 1u);
    return b;
}
__device__ __forceinline__ void xcd_barrier_complete(unsigned* bar, unsigned x, unsigned& nloc, unsigned& nx) {
    const unsigned G = gridDim.x * gridDim.y * gridDim.z;
    unsigned sum, cnt, mine, sp = 0u;
    for (;;) {
        sum = 0u; cnt = 0u; mine = 0u;
#pragma unroll
        for (unsigned j = 0; j < 16; ++j) { const unsigned c = xb_ld(&bar[XB_XCNT(j)]); sum += c; cnt += (c > 0u) ? 1u : 0u; mine = (j == x) ? c : mine; }
        if (sum == G) break;
        __builtin_amdgcn_s_sleep(1);
        if ((++sp & 255u) == 0u) { if (xb_ld(&bar[XB_TMO])) break; if (sp > XB_SPIN_CAP) { atomicAdd(&bar[XB_TMO], 1u); break; } }
    }
    nloc = mine > 0u ? mine : 1u; nx = cnt > 0u ? cnt : 1u;
}
__device__ __forceinline__ void xcd_barrier(const XcdBarrier& b) {
    asm volatile("s_waitcnt vmcnt(0)" ::: "memory");
    __syncthreads();
    if (threadIdx.x == 0) {
        unsigned* bar = b.bar;
        __builtin_amdgcn_s_waitcnt(0);
        unsigned nloc = b.st[0], nx = b.st[1];
        if (nloc == 0u) { xcd_barrier_complete(bar, b.x, nloc, nx); b.st[0] = nloc; b.st[1] = nx; }
        const unsigned old = xb_add(&bar[XB_XSUB(b.x)], 1u);
        const unsigned gen = old / nloc;
        if (old + 1u == (gen + 1u) * nloc) {
            __builtin_amdgcn_fence(__ATOMIC_RELEASE, "agent");
            asm volatile("s_waitcnt vmcnt(0)" ::: "memory");
            const unsigned og = xb_add(&bar[XB_TOP], 1u);
            const unsigned tg = og / nx;
            if (og + 1u == (tg + 1u) * nx) xb_add(&bar[XB_TOPGEN], 1u);
            else XB_SPIN(xb_ld(&bar[XB_TOPGEN]) == tg, bar);
            __builtin_amdgcn_fence(__ATOMIC_ACQUIRE, "agent");
            xb_add(&bar[XB_XGEN(b.x)], 1u);
            asm volatile("s_waitcnt vmcnt(0)" ::: "memory");
        } else {
            XB_SPIN(xb_ld(&bar[XB_XGEN(b.x)]) == gen, bar);
            __builtin_amdgcn_fence(__ATOMIC_ACQUIRE, "agent");
            asm volatile("s_waitcnt vmcnt(0)" ::: "memory");
        }
    }
    __syncthreads();
}

__global__ void __launch_bounds__(512, 2) hybrid_fwd(Args a) {
    extern __shared__ __attribute__((aligned(16))) unsigned char lds_raw[];
    cg::grid_group grid = cg::this_grid();
    LAS unsigned char* ldsL = (LAS unsigned char*)lds_raw;
    const int G = gridDim.x, NGW = G * 8;
    { volatile LAS unsigned* z = (volatile LAS unsigned*)(ldsL + LDS_BYTES - 32); if (threadIdx.x < 2) z[threadIdx.x] = 0u; }
    __syncthreads();
    const XcdBarrier xbar = xcd_barrier_post((unsigned*)(a.ws + WS_CTL) + 4096, (volatile LAS unsigned*)(ldsL + LDS_BYTES - 32));
#define WSB() ({ size_t z_ = 0; asm volatile("" : "+s"(z_)); a.ws + z_; })

#if !defined(OFF_P0)
    for (int rep0 = 0; rep0 < 1 + DUP_P0; ++rep0) {
        const int tid = otid(), lane = tid & 63, wid = __builtin_amdgcn_readfirstlane(tid >> 6), gw = blockIdx.x * 8 + wid; (void)tid; (void)lane; (void)gw;
        LAS float* scr = (LAS float*)(ldsL + wid * 16384);
        constexpr int I_A = 16 * 128, I_B = 16 * 96, I_C = 16 * 64;
        constexpr int NITEMS = I_A + I_B + I_C;
        for (int it = gw; it < NITEMS; it += NGW) {
            int r = it;
            if (r < I_A) { p0_transpose_item(a.w_in, DM, NIN, ((bf16_t*)(WSB() + WS_WIN)), 0, 0, 4096, scr, r, lane); continue; } r -= I_A;
            if (r < I_B) { p0_transpose_item(a.w_in, DM, NIN, ((bf16_t*)(WSB() + WS_WIN)), 4112, 4096, 3072, scr, r, lane); continue; } r -= I_B;
            p0_transpose_item(a.w_in, DM, NIN, ((bf16_t*)(WSB() + WS_WIN)), 7192, 7168, 2048, scr, r, lane);
        }
        __syncthreads();
        float* wsm = (float*)lds_raw;
        {
            f32x4 wv[2][6]; const float gk[2] = {a.norm_mix_g[tid], a.norm_mix_g[tid + 512]};
#pragma unroll
            for (int kk = 0; kk < 2; ++kk) { const float* wr_ = a.w_in + (size_t)(tid + 512 * kk) * NIN;
#pragma unroll
                for (int q = 0; q < 4; ++q) wv[kk][q] = *(const f32x4*)(wr_ + 4096 + 4 * q);
                wv[kk][4] = *(const f32x4*)(wr_ + 7184); wv[kk][5] = *(const f32x4*)(wr_ + 7188); }
#pragma unroll
            for (int kk = 0; kk < 2; ++kk)
#pragma unroll
                for (int q = 0; q < 6; ++q)
#pragma unroll
                    for (int i = 0; i < 4; ++i) wsm[(4 * q + i) * 1024 + tid + 512 * kk] = wv[kk][q][i] * gk[kk];
        }
        __syncthreads();
        if (wid < 4) {
            typedef float f32x16v __attribute__((ext_vector_type(16)));
            const int i = lane & 31, kk = lane >> 5;
            float* rsl = (float*)(lds_raw + 98304) + wid * 32;
            for (int tile = blockIdx.x * 4 + wid; tile < MTOT / 32; tile += G * 4) {
                const float* xr = a.x + (size_t)(32 * tile + i) * DM + kk * 4;
                const float* wl = wsm + (i < 24 ? i : 0) * 1024 + kk * 4;
                f32x16v acc = {}; float ssq = 0.f;
#pragma unroll 16
                for (int c = 0; c < 128; ++c) { const f32x4 av = *(const f32x4*)(xr + c * 8); const f32x4 bv = *(const f32x4*)(wl + c * 8);
                    ssq += (av.x * av.x + av.y * av.y) + (av.z * av.z + av.w * av.w);
                    acc = __builtin_amdgcn_mfma_f32_32x32x2f32(av.x, bv.x, acc, 0, 0, 0); acc = __builtin_amdgcn_mfma_f32_32x32x2f32(av.y, bv.y, acc, 0, 0, 0);
                    acc = __builtin_amdgcn_mfma_f32_32x32x2f32(av.z, bv.z, acc, 0, 0, 0); acc = __builtin_amdgcn_mfma_f32_32x32x2f32(av.w, bv.w, acc, 0, 0, 0); }
                { auto rr = __builtin_amdgcn_permlane32_swap(__float_as_uint(ssq), __float_as_uint(ssq), false, false); ssq = __uint_as_float(rr[0]) + __uint_as_float(rr[1]); }
                if (kk == 0) rsl[i] = __builtin_amdgcn_rsqf(ssq * (1.f / DM) + EPS);
                asm volatile("s_waitcnt lgkmcnt(0)" ::: "memory");
                if (i < 24) {
#pragma unroll
                    for (int g = 0; g < 4; ++g) { const f32x4 r4 = *(const f32x4*)(rsl + 8 * g + 4 * kk);
#pragma unroll
                        for (int q = 0; q < 4; ++q) ((float*)(WSB() + WS_SMALL))[(size_t)(32 * tile + 8 * g + 4 * kk + q) * 24 + i] = acc[4 * g + q] * r4[q]; } }
                asm volatile("s_waitcnt lgkmcnt(0)" ::: "memory");
            }
        } else {
            const int gw4 = blockIdx.x * 4 + (wid - 4), NGW4 = G * 4;
            for (int m = gw4; m < MTOT; m += 2 * NGW4) {
                f32x4 va[4], vb[4];
                rms_load(a.x + (size_t)m * DM, lane, va); rms_load(a.x + (size_t)(m + NGW4) * DM, lane, vb);
                rms_finish(a.norm_mix_g, ((bf16_t*)((unsigned char*)a.out + 64 * MiB)) + (size_t)m * DM, lane, va); rms_finish(a.norm_mix_g, ((bf16_t*)((unsigned char*)a.out + 64 * MiB)) + (size_t)(m + NGW4) * DM, lane, vb);
            }
        }
        __syncthreads();
    }
#endif
    if (a.cg_seam) grid.sync(); else GSYNC();

    for (int half = 0; half < NHALF; ++half) {
        const size_t roff = (size_t)half * MH;
#if !defined(OFF_G1)
        {
            pg8::Gemm g{((bf16_t*)((unsigned char*)a.out + 64 * MiB)) + roff * DM, ((bf16_t*)(WSB() + WS_WIN)), MH, NPROJ, DM}; pg8::StaticOrder S; S.init(MH, NPROJ, G, (int)blockIdx.x);
            pg8::EpiBf16<0> E{((bf16_t*)(WSB() + WS_PROJ + (size_t)(0) * GRP)), DM, DM, GRP / 2, 4, 7, 4, 6, a.fq_g, a.fk_g, (LAS float*)(ldsL + 131072), nullptr};
            for (int rep = 0; rep < 1 + DUP_G1; ++rep)
            pg8::gemm_phase<pg8::EpiBf16<0>, pg8::StaticOrder, true>(ldsL, g, S, E);
        }
#endif
        GSYNC();
        {
#if !defined(OFF_PREPAB)
            const int tid = otid(), lane = tid & 63, wid = __builtin_amdgcn_readfirstlane(tid >> 6), gw = blockIdx.x * 8 + wid; (void)tid; (void)lane; (void)gw;
            for (int bh = gw; bh < BH * NH; bh += NGW) { const int bl = bh >> 3, h = bh & 7; const float fb = a.f_bias[h];
                const float* sp = ((float*)(WSB() + WS_SMALL)) + (roff + (size_t)bl * SEQ + lane * 32) * 24 + 16 + h; float loc[32]; float run = 0.f;
#pragma unroll
                for (int i = 0; i < 32; ++i) { const float xv = sp[(size_t)i * 24] + fb; const float ls = fminf(xv, 0.f) - log1pf(__expf(-fabsf(xv))); run += ls; loc[i] = run; }
                float inc = run;
#pragma unroll
                for (int o = 1; o < 64; o <<= 1) { const float up = __shfl_up(inc, o); if (lane >= o) inc += up; }
                const float excl = inc - run; float* cp = ((float*)(WSB() + WS_CB)) + ((size_t)(half * BH * NH + bh)) * SEQ + lane * 32;
#pragma unroll
                for (int i = 0; i < 32; ++i) cp[i] = -(excl + loc[i]) * (1.f / SM_SCALE); }
#endif
#ifndef NO_INTRA
            { u32x4 rv[7]; int hprev = -1; const int NU = BH * NH * NCH;
              gdn::raw_load(rv, blockIdx.x, tid, ((bf16_t*)(WSB() + WS_PROJ + (size_t)(0) * GRP)), ((bf16_t*)(WSB() + WS_PROJ + (size_t)(1) * GRP)), ((bf16_t*)(WSB() + WS_PROJ + (size_t)(2) * GRP)));
              for (int u = blockIdx.x; u < NU; u += G)
                  gdn::intra_unit(lds_raw, u, u + G < NU ? u + G : u  , rv, hprev, half, ((bf16_t*)(WSB() + WS_PROJ + (size_t)(0) * GRP)), ((bf16_t*)(WSB() + WS_PROJ + (size_t)(1) * GRP)), ((bf16_t*)(WSB() + WS_PROJ + (size_t)(2) * GRP)), ((float*)(WSB() + WS_SMALL)), a.conv_w, a.a_log, a.dt_bias, (WSB() + WS_IO), ((float*)(WSB() + WS_DEC))); }
#endif
        }
        GSYNC();
        {
            const int tid = otid(), lane = tid & 63, wid = __builtin_amdgcn_readfirstlane(tid >> 6), gw = blockIdx.x * 8 + wid; (void)tid; (void)lane; (void)gw;
            LAS int* s_item = (LAS int*)(ldsL + LDS_BYTES - 64);
            for (int rep = 0; rep < 1 + (DUP_SA ? 1 : 0); ++rep) {
            const int xcd = blockIdx.x & 7;
            unsigned* ctr = ((unsigned*)(WSB() + WS_CTL)) + 64 * (8 + (half * 2 + rep) * 8 + xcd);
            if (rep) xcd_barrier(xbar);
            const int NIT = (rep && DUP_SA == 2) ? 64 : 64 + 512;
            fa::Seam S = {}; bool primed = false; int cbsel = 0;
            fa::NextCtx nc; nc.ctr = ctr; nc.s_item = (int*)(lds_raw + LDS_BYTES - 64); nc.Qb = ((bf16_t*)(WSB() + WS_PROJ + (size_t)(4) * GRP)); nc.Kb = ((bf16_t*)(WSB() + WS_PROJ + (size_t)(5) * GRP)); nc.Vb = ((bf16_t*)(WSB() + WS_PROJ + (size_t)(6) * GRP)); nc.Ob = ((bf16_t*)(WSB() + WS_PROJ + 2 * GRP)); nc.cb = ((float*)(WSB() + WS_CB)) + (size_t)(half * BH * NH) * SEQ; nc.nit = NIT; nc.xcd = xcd;
#define Q_FETCH(dst) do { if (tid == 0) *s_item = (int)atomicAdd(ctr, 1u); __syncthreads(); dst = __builtin_amdgcn_readfirstlane(fa::decode_item(*s_item, xcd)); __syncthreads(); } while (0)
            const int NTR = (rep ? 0 : (half == 0 ? 192 : 512));
            int it; Q_FETCH(it);
            while (it < NIT) {
#ifndef NO_SCAN
                if (it < 64) { gdn::scan_unit(lds_raw, it, (WSB() + WS_IO), ((float*)(WSB() + WS_DEC)), ((bf16_t*)(WSB() + WS_PROJ)), ((bf16_t*)(WSB() + WS_PROJ + (size_t)(3) * GRP)), a.gdn_norm_g); primed = false; S = fa::Seam{}; Q_FETCH(it); continue; }
#endif
#ifndef NO_ATTN
                {
                    const fa::BlockRef cur = fa::item_ref(nc, it);
                    if (!primed) {
                        float* cbl = (float*)(lds_raw + fa::LDS_CB + cbsel * 8192);
                        if (tid * 4 < cur.P0 + 256) *(f32x4*)(cbl + tid * 4) = *(const f32x4*)(fa::item_cb(nc, it) + tid * 4);
                        fa::attn_prime(cur, (char*)lds_raw, S); }
                    int itn;
                    fa::attn_block(cur, (char*)lds_raw, S, cbsel, nc, itn);
                    primed = itn >= 64 && itn < NIT; if (primed) cbsel ^= 1;
                    it = itn;
                }
#else
                Q_FETCH(it);
#endif
            }
            while (it >= 2048 && it < 2048 + NTR) {
                const int witem = (it - 2048) * 8 + wid; LAS float* scr = (LAS float*)(ldsL + wid * 16384);
                if (half == 0) { const int m = witem >> 9, r = witem & 511; p0_transpose_item<8>(m == 0 ? a.w_pa : (m == 1 ? a.w_pb : a.w_out), DM, DM, m == 0 ? ((bf16_t*)(WSB() + WS_WPA)) : (m == 1 ? ((bf16_t*)(WSB() + WS_WPB)) : ((bf16_t*)(WSB() + WS_WOUT))), 0, 0, DM, scr, r, lane); }
                else { if (witem < 2048) p0_transpose_item<8>(a.w_up, DM, DFF, ((bf16_t*)(WSB() + WS_WUP)), 0, 0, DFF, scr, witem, lane, a.norm_mlp_g); else p0_transpose_item<8>(a.w_dn, DFF, DM, ((bf16_t*)(WSB() + WS_WDN)), 0, 0, DM, scr, witem - 2048, lane); }
                __syncthreads(); Q_FETCH(it); }
#undef Q_FETCH
#undef A_REF
#undef A_CB
            }
        }
#if 0
        {
            const int tid = otid(), lane = tid & 63, wid = __builtin_amdgcn_readfirstlane(tid >> 6), gw = blockIdx.x * 8 + wid; (void)tid; (void)lane; (void)gw;
            for (int m = gw; m < MH; m += 2 * NGW) {
                u32x4 xin[2][4];
#pragma unroll
                for (int q = 0; q < 2; ++q) { const bf16_t* p = ((bf16_t*)(WSB() + WS_PROJ)) + (size_t)(m + q * NGW) * DM + lane * 16; const bf16_t* zp = ((bf16_t*)(WSB() + WS_PROJ + (size_t)(3) * GRP)) + (size_t)(m + q * NGW) * DM + lane * 16;
                    xin[q][0] = *(const u32x4*)p; xin[q][1] = *(const u32x4*)(p + 8); xin[q][2] = *(const u32x4*)zp; xin[q][3] = *(const u32x4*)(zp + 8); }
#pragma unroll
                for (int q = 0; q < 2; ++q) { bf16_t* p = ((bf16_t*)(WSB() + WS_PROJ)) + (size_t)(m + q * NGW) * DM + lane * 16; const float* gg = a.gdn_norm_g + (lane & 7) * 16;
                    const u32x4 x0 = xin[q][0], x1 = xin[q][1], z0 = xin[q][2], z1 = xin[q][3];
                    float f[16] = {bflo(x0.x), bfhi(x0.x), bflo(x0.y), bfhi(x0.y), bflo(x0.z), bfhi(x0.z), bflo(x0.w), bfhi(x0.w),
                                   bflo(x1.x), bfhi(x1.x), bflo(x1.y), bfhi(x1.y), bflo(x1.z), bfhi(x1.z), bflo(x1.w), bfhi(x1.w)};
                    float z[16] = {bflo(z0.x), bfhi(z0.x), bflo(z0.y), bfhi(z0.y), bflo(z0.z), bfhi(z0.z), bflo(z0.w), bfhi(z0.w),
                                   bflo(z1.x), bfhi(z1.x), bflo(z1.y), bfhi(z1.y), bflo(z1.z), bfhi(z1.z), bflo(z1.w), bfhi(z1.w)};
                    float s = 0.f;
#pragma unroll
                    for (int i = 0; i < 16; ++i) s += f[i] * f[i];
                    s += __shfl_xor(s, 1); s += __shfl_xor(s, 2); s += __shfl_xor(s, 4);
                    const float rstd = __builtin_amdgcn_rsqf(s * (1.f / HD) + EPS);
#pragma unroll
                    for (int i = 0; i < 16; ++i) f[i] = f[i] * rstd * gg[i] * siluf_(z[i]);
                    u32x4 y0, y1; y0.x = cvtpk(f[0], f[1]); y0.y = cvtpk(f[2], f[3]); y0.z = cvtpk(f[4], f[5]); y0.w = cvtpk(f[6], f[7]);
                    y1.x = cvtpk(f[8], f[9]); y1.y = cvtpk(f[10], f[11]); y1.z = cvtpk(f[12], f[13]); y1.w = cvtpk(f[14], f[15]);
                    *(u32x4*)p = y0; *(u32x4*)(p + 8) = y1; }
            }
        }
#endif
        GSYNC();
#if !defined(OFF_G2)
        {
            static_assert(WS_WPB == WS_WPA + (size_t)DM * DM * 2, "P_B's bf16 copy must follow P_A's: the second stage's B tiles are addressed as rows 1024.. of one [2048][1024] matrix");
            pg8::Gemm g{((bf16_t*)(WSB() + WS_PROJ)), ((bf16_t*)(WSB() + WS_WPA)), MH, DM, DM, (const bf16_t*)(WSB() + WS_PROJ + 2 * GRP), MH / 256};
            pg8::TwoStageOrder S; S.base.init(MH, DM, G, (int)blockIdx.x); S.dpm = MH / 256; S.dpn = DM / 256;
            pg8::EpiGate E{((bf16_t*)(WSB() + WS_PROJ + (size_t)(7) * GRP)), ((bf16_t*)(WSB() + WS_PROJ + (size_t)(8) * GRP)), (bf16_t*)(WSB() + (half == 0 ? WS_MG0 : WS_PROJ + 3 * GRP)), MH / 256, DM / 256};
            pg8::gemm_phase<pg8::EpiGate, pg8::TwoStageOrder, true>(ldsL, g, S, E);
        }
#endif
        GSYNC();
    }
#if !defined(OFF_G4)
    {
        pg8::Gemm g{(const bf16_t*)(WSB() + WS_MG0), ((bf16_t*)(WSB() + WS_WOUT)), MTOT, DM, DM, (const bf16_t*)(WSB() + WS_PROJ + 3 * GRP), MH / 256}; pg8::StaticOrder S; S.init(MTOT, DM, G, (int)blockIdx.x);
        pg8::EpiResF32<true> E{a.x, a.out, (bf16_t*)(WSB() + WS_HB), (float*)(WSB() + WS_HSS), (LAS float*)(ldsL + 131072)};
        for (int r4 = 0; r4 < 1 + DUP_G4; ++r4)
        pg8::gemm_phase<pg8::EpiResF32<true>, pg8::StaticOrder, true>(ldsL, g, S, E);
    }
#endif
    GSYNC();
    bf16_t* ACT = (bf16_t*)(WSB() + WS_ACT);
#if !defined(OFF_G5)
    {
        pg8::Gemm g{(const bf16_t*)(WSB() + WS_HB), ((bf16_t*)(WSB() + WS_WUP)), MTOT, DFF, DM}; pg8::StaticOrder S; S.init(MTOT, DFF, G, (int)blockIdx.x);
        pg8::EpiBf16<2> E{ACT, DFF, 0, 0, 0, 0, 0, 0, nullptr, nullptr, (LAS float*)(ldsL + 131072), (const float*)(WSB() + WS_HSS)};
        for (int r5 = 0; r5 < 1 + DUP_G5; ++r5)
        pg8::gemm_phase<pg8::EpiBf16<2>, pg8::StaticOrder, true>(ldsL, g, S, E);
    }
#endif
    GSYNC();
#if !defined(OFF_G6)
    {
        pg8::Gemm g{ACT, ((bf16_t*)(WSB() + WS_WDN)), MTOT, DM, DFF}; pg8::StaticOrder S; S.init(MTOT, DM, G, (int)blockIdx.x);
        pg8::EpiResF32<false> E{a.out, a.out, nullptr, nullptr, (LAS float*)(ldsL + 131072)};
        pg8::gemm_phase<pg8::EpiResF32<false>, pg8::StaticOrder, true>(ldsL, g, S, E);
    }
#endif
}

extern "C" void kernel_launch(void* const* d_in, const int* in_sizes, int n_in, void* d_out, int out_size, void* d_ws, size_t ws_size, hipStream_t stream) {
    static int grid = 0;
    if (grid == 0) {
        if (n_in != 16 || in_sizes[0] != MTOT * DM || out_size != MTOT * DM || ws_size < WS_END) {
            fprintf(stderr, "kernel_launch: unexpected shapes / workspace (n_in %d, in0 %d, out %d, ws %zu)\n", n_in, n_in > 0 ? in_sizes[0] : -1, out_size, ws_size); grid = -1; return; }
        int dev = 0, cus = 0, per_cu = 0;
        (void)hipGetDevice(&dev); (void)hipDeviceGetAttribute(&cus, hipDeviceAttributeMultiprocessorCount, dev);
        if (hipFuncSetAttribute((const void*)hybrid_fwd, hipFuncAttributeMaxDynamicSharedMemorySize, LDS_BYTES) != hipSuccess) { fprintf(stderr, "kernel_launch: hipFuncSetAttribute failed\n"); grid = -1; return; }
        if (hipOccupancyMaxActiveBlocksPerMultiprocessor(&per_cu, (const void*)hybrid_fwd, 512, LDS_BYTES) != hipSuccess || per_cu < 1) { fprintf(stderr, "kernel_launch: occupancy query says %d\n", per_cu); per_cu = 1; }
        (void)hipGetLastError();
        grid = cus * 1;
        if (grid <= 0) grid = 256;
    }
    if (grid < 0) return;
    (void)hipMemsetAsync((char*)d_ws + WS_CTL, 0, 65536, stream);
    Args a{};
    a.x = (const float*)d_in[0]; a.norm_mix_g = (const float*)d_in[1]; a.w_in = (const float*)d_in[2]; a.conv_w = (const float*)d_in[3];
    a.a_log = (const float*)d_in[4]; a.dt_bias = (const float*)d_in[5]; a.gdn_norm_g = (const float*)d_in[6]; a.fq_g = (const float*)d_in[7];
    a.fk_g = (const float*)d_in[8]; a.f_bias = (const float*)d_in[9]; a.w_pa = (const float*)d_in[10]; a.w_pb = (const float*)d_in[11];
    a.w_out = (const float*)d_in[12]; a.norm_mlp_g = (const float*)d_in[13]; a.w_up = (const float*)d_in[14]; a.w_dn = (const float*)d_in[15];
    a.out = (float*)d_out; a.ws = (unsigned char*)d_ws; a.cg_seam = 0; a.pad = 0;
    void* args[] = {&a};
    hipError_t e = hipLaunchCooperativeKernel((const void*)hybrid_fwd, dim3(grid), dim3(512), args, LDS_BYTES, stream);
    if (e != hipSuccess) fprintf(stderr, "kernel_launch: cooperative launch failed: %s (grid %d)\n", hipGetErrorString(e), grid);
}
```
